# Optimizing an MI355X kernel written in HIP

```python
import math
import jax, jax.numpy as jnp
from jax import lax
import numpy as np

D_MODEL = 2048
BATCH = 4
SEQ = 2048
DEPTH = 4

ATTN_WIDTH = D_MODEL // 2
CONV_WIDTH = D_MODEL - ATTN_WIDTH
N_HEADS = 8
HEAD_DV = ATTN_WIDTH // N_HEADS
HEAD_DK = HEAD_DV // 2
N_CONV_GROUPS = 8
CONV_K = 3
D_FF = 4 * D_MODEL
NUM_BUCKETS = 32
MAX_DISTANCE = 128
MAX_EXACT = NUM_BUCKETS // 2
Q_BLOCK = 128
EPS = 1e-6
NEG = -1e30
PROJ_WIDTH = 3 * ATTN_WIDTH + 3 * CONV_WIDTH

kernel_name = "hybrid_diffattn_shortconv_sqrelu"


def _rmsnorm(x, g):
    x32 = x.astype(jnp.float32)
    y = x32 * lax.rsqrt(jnp.mean(x32 * x32, axis=-1, keepdims=True) + EPS)
    return (y * g.astype(jnp.float32)).astype(x.dtype)


def _relative_bucket(dist):
    n = jnp.maximum(dist, 0)
    is_small = n < MAX_EXACT
    nf = jnp.maximum(n, MAX_EXACT).astype(jnp.float32)
    large = MAX_EXACT + (jnp.log(nf / MAX_EXACT) / math.log(MAX_DISTANCE / MAX_EXACT)
                         * (NUM_BUCKETS - MAX_EXACT)).astype(jnp.int32)
    large = jnp.minimum(large, NUM_BUCKETS - 1)
    return jnp.where(is_small, n, large)


def _diff_attention(q, k, v, lam, rel_bias):
    B, S, H, _, dk = q.shape
    dv = v.shape[-1]
    nblk = S // Q_BLOCK
    k_pos = jnp.arange(S, dtype=jnp.int32)
    scale = dk ** -0.5

    def block(args):
        qb, start = args
        q_pos = start + jnp.arange(Q_BLOCK, dtype=jnp.int32)
        dist = q_pos[:, None] - k_pos[None, :]
        bias = jnp.take(rel_bias, _relative_bucket(dist), axis=0)
        bias = bias.reshape(Q_BLOCK, S, H, 2).transpose(2, 3, 0, 1).astype(jnp.float32)
        s = jnp.einsum('bqhmd,bkhmd->bhmqk', qb, k).astype(jnp.float32) * scale + bias
        s = jnp.where(dist >= 0, s, NEG)
        p = jax.nn.softmax(s, axis=-1)
        p = p[:, :, 0] - lam * p[:, :, 1]
        return jnp.einsum('bhqk,bkhd->bqhd', p.astype(v.dtype), v)

    qb = q.reshape(B, nblk, Q_BLOCK, H, 2, dk).transpose(1, 0, 2, 3, 4, 5)
    starts = jnp.arange(nblk, dtype=jnp.int32) * Q_BLOCK
    out = lax.map(block, (qb, starts))
    return out.transpose(1, 0, 2, 3, 4).reshape(B, S, H, dv)


def _short_conv(u, w):
    S = u.shape[1]
    up = jnp.pad(u, ((0, 0), (CONV_K - 1, 0), (0, 0)))
    return sum(w[i] * up[:, i:i + S] for i in range(CONV_K))


def setup_inputs(seed: int = 0) -> dict:
    key = jax.random.key(seed)
    ks = jax.random.split(key, 16)
    f32 = jnp.float32

    def nrm(k, shape, scale):
        return jax.random.normal(k, shape, f32) * scale

    def gain(k, shape):
        return 1.0 + 0.02 * jax.random.normal(k, shape, f32)

    return {
        "x": nrm(ks[0], (BATCH, SEQ, D_MODEL), 1.0),
        "w_in": nrm(ks[1], (DEPTH, D_MODEL, PROJ_WIDTH), D_MODEL ** -0.5),
        "w_out": nrm(ks[2], (DEPTH, ATTN_WIDTH + CONV_WIDTH, D_MODEL), (ATTN_WIDTH + CONV_WIDTH) ** -0.5),
        "conv_w": nrm(ks[3], (DEPTH, CONV_K, CONV_WIDTH), CONV_K ** -0.5),
        "q_norm_g": gain(ks[4], (DEPTH, HEAD_DK)),
        "k_norm_g": gain(ks[5], (DEPTH, HEAD_DK)),
        "lambda_q1": nrm(ks[6], (DEPTH, HEAD_DK), 0.1),
        "lambda_k1": nrm(ks[7], (DEPTH, HEAD_DK), 0.1),
        "lambda_q2": nrm(ks[8], (DEPTH, HEAD_DK), 0.1),
        "lambda_k2": nrm(ks[9], (DEPTH, HEAD_DK), 0.1),
        "subln_g": gain(ks[10], (DEPTH, HEAD_DV)),
        "attn_norm_g": gain(ks[11], (DEPTH, D_MODEL)),
        "mlp_norm_g": gain(ks[12], (DEPTH, D_MODEL)),
        "w_up": nrm(ks[13], (DEPTH, D_MODEL, D_FF), D_MODEL ** -0.5),
        "w_down": nrm(ks[14], (DEPTH, D_FF, D_MODEL), D_FF ** -0.5),
        "rel_bias": nrm(ks[15], (NUM_BUCKETS, 2 * N_HEADS), 0.5),
    }


def reference(x, w_in, w_out, conv_w, q_norm_g, k_norm_g, lambda_q1, lambda_k1,
              lambda_q2, lambda_k2, subln_g, attn_norm_g, mlp_norm_g, w_up, w_down,
              rel_bias):
    B, S, _ = x.shape
    splits = [ATTN_WIDTH, 2 * ATTN_WIDTH, 3 * ATTN_WIDTH,
              3 * ATTN_WIDTH + CONV_WIDTH, 3 * ATTN_WIDTH + 2 * CONV_WIDTH]
    for l in range(DEPTH):
        h = _rmsnorm(x, attn_norm_g[l])
        proj = h @ w_in[l]
        q, k, v, gate_b, gate_c, conv_in = jnp.split(proj, splits, axis=-1)

        q = _rmsnorm(q.reshape(B, S, N_HEADS, 2, HEAD_DK), q_norm_g[l])
        k = _rmsnorm(k.reshape(B, S, N_HEADS, 2, HEAD_DK), k_norm_g[l])
        v = v.reshape(B, S, N_HEADS, HEAD_DV)
        lam_init = 0.8 - 0.6 * math.exp(-0.3 * l)
        lam = (jnp.exp(jnp.sum(lambda_q1[l].astype(jnp.float32) * lambda_k1[l].astype(jnp.float32)))
               - jnp.exp(jnp.sum(lambda_q2[l].astype(jnp.float32) * lambda_k2[l].astype(jnp.float32)))
               + lam_init)
        attn = _diff_attention(q, k, v, lam, rel_bias)
        attn = (_rmsnorm(attn, subln_g[l]) * (1.0 - lam_init)).reshape(B, S, ATTN_WIDTH)

        conv = gate_b * _short_conv(gate_c * conv_in, conv_w[l])

        x = x + jnp.concatenate([attn, conv.astype(attn.dtype)], axis=-1) @ w_out[l]

        hm = _rmsnorm(x, mlp_norm_g[l]) @ w_up[l]
        x = x + jnp.square(jax.nn.relu(hm)) @ w_down[l]
    return x
```

```cpp
#include <hip/hip_runtime.h>
#include <hip/hip_bf16.h>
#include <hip/hip_cooperative_groups.h>
#include <cstdio>
#include <cstdint>
#include <cmath>
namespace cg = cooperative_groups;
namespace pg8 {
#define PG8_LAS __attribute__((address_space(3)))
typedef unsigned short bf16_t;
typedef short bf16x8 __attribute__((ext_vector_type(8)));
typedef float f32x4 __attribute__((ext_vector_type(4)));
typedef unsigned u32x4 __attribute__((ext_vector_type(4)));
constexpr int BM = 256, BK = 64, HALF = 128, HTB = HALF * BK * 2  , STAGE_BYTES = 8 * HTB, NXCD = 8, WGM = 8;

__host__ __device__ __forceinline__ int lds_byte(int r, int c) { const int st = (r >> 4) * 2 + (c >> 5), rr = r & 15, cc = c & 31, ob = rr * 64 + cc * 2; return st * 1024 + (ob ^ (((ob >> 9) & 1) << 5)); }
__host__ __device__ __forceinline__ void stage_rc(int b, int& R, int& C) { const int st = b / 1024, sb = b % 1024, swz = sb ^ (((sb >> 9) & 1) << 5); R = (st >> 1) * 16 + swz / 64; C = (st & 1) * 32 + (swz % 64) / 2; }
__host__ __device__ __forceinline__ int perm32(int rho) { const int n = rho >> 4, i = rho & 15; return 8 * (i >> 2) + 4 * n + (i & 3); }

struct Unit { int pm, pn; };
struct Gemm { const bf16_t* A; const bf16_t* Bt; int M, N, K; int a_blocked; };

struct StaticOrder {
    int nM, nN, nwg, G, c;
    __host__ __device__ void init(int M, int N, int G_, int c_) { nM = M / BM; nN = N / BM; nwg = nM * nN; G = G_; c = c_; }
    __host__ __device__ bool next(int i, Unit& u) const {
        const long L = (long)i * G + c; if (L >= nwg) return false;
        int wgid = (int)L; { const int q = nwg / NXCD, r = nwg % NXCD, xcd = wgid % NXCD, off = wgid / NXCD; wgid = (xcd < r ? xcd * (q + 1) : r * (q + 1) + (xcd - r) * q) + off; }
        const int nig = WGM * nN, gid = wgid / nig, fm = gid * WGM, gsz = (nM - fm) < WGM ? (nM - fm) : WGM;
        u.pm = fm + ((wgid % nig) % gsz); u.pn = (wgid % nig) / gsz; return true;
    }
    __device__ __forceinline__ void a_ready(const Unit&) const {}
    __device__ __forceinline__ void done(const Unit&) const {}
};

__device__ __forceinline__ unsigned cvt_pk_bf16(float lo, float hi) { unsigned r; asm volatile("v_cvt_pk_bf16_f32 %0, %1, %2" : "=v"(r) : "v"(lo), "v"(hi)); return r; }
typedef float f32x2 __attribute__((ext_vector_type(2)));
constexpr float RMS_EPS = 1e-6f;
constexpr float QC2 = 0.125f * 1.4426950408889634f;
typedef unsigned u32x2e __attribute__((ext_vector_type(2)));
__device__ __forceinline__ float row_rstd(const float* ssq, int row) {
    const f32x4* p = (const f32x4*)(ssq + (size_t)row * 32); f32x4 a = p[0];
#pragma unroll
    for (int i = 1; i < 8; ++i) a = a + p[i];
    return 1.0f / sqrtf(((a[0] + a[1]) + (a[2] + a[3])) * (1.0f / 2048.0f) + RMS_EPS);
}
__device__ __forceinline__ void zero_acc(f32x4 (&acc)[2][2][4][2]) {
#pragma unroll
    for (int a = 0; a < 2; ++a)
#pragma unroll
        for (int b = 0; b < 2; ++b)
#pragma unroll
            for (int m = 0; m < 4; ++m)
#pragma unroll
                for (int n = 0; n < 2; ++n) acc[a][b][m][n] = (f32x4){0.f, 0.f, 0.f, 0.f};
}
__device__ __forceinline__ void rows_rstd(float (&rs)[2][4], const float* ssq, int row0, int fq) {
    f32x4 pa[2][4], pb[2][4];
#pragma unroll
    for (int ai = 0; ai < 2; ++ai)
#pragma unroll
        for (int m = 0; m < 4; ++m) { const f32x4* p = (const f32x4*)(ssq + (size_t)(row0 + ai * HALF + m * 16) * 32 + 8 * fq); pa[ai][m] = p[0]; pb[ai][m] = p[1]; }
#pragma unroll
    for (int ai = 0; ai < 2; ++ai)
#pragma unroll
        for (int m = 0; m < 4; ++m) { const f32x4 a = pa[ai][m] + pb[ai][m]; float t = (a[0] + a[1]) + (a[2] + a[3]);
            t += __shfl_xor(t, 16); t += __shfl_xor(t, 32); rs[ai][m] = 1.0f / sqrtf(t * (1.0f / 2048.0f) + RMS_EPS); }
}
struct RsState { f32x4 ra, rb; int pm; };
struct NoState { int pm; };
struct EpiProj {
    typedef RsState State; static constexpr int KR = 1;
    static constexpr bool PERM = true, AFTER_DRAIN = false;
    bf16_t* O; const float* ssq; const float* qg; const float* kg; int ldc; bf16_t* KH; bf16_t* VH;
    __device__ __forceinline__ void init(f32x4 (&acc)[2][2][4][2], State& st, const Unit& u, int wr, int, int fr, int fq) const { zero_acc(acc);
        if (st.pm != u.pm) { float t[2][4]; rows_rstd(t, ssq, u.pm * BM + wr * 64 + fr, fq); st.ra = (f32x4){t[0][0], t[0][1], t[0][2], t[0][3]}; st.rb = (f32x4){t[1][0], t[1][1], t[1][2], t[1][3]}; st.pm = u.pm; } }
    __device__ __forceinline__ void operator()(const f32x4 (&acc)[2][2][4][2], const State& st, const Unit& u, int wr, int wc, int fr, int fq) const {
        const int row0 = u.pm * BM + wr * 64 + fr, col0 = u.pn * BM + wc * 64 + 8 * fq;
        const float rsv[2][4] = {{st.ra[0], st.ra[1], st.ra[2], st.ra[3]}, {st.rb[0], st.rb[1], st.rb[2], st.rb[3]}};
        const bool qk = u.pn < 8, isq = u.pn < 4;
        f32x4 g[2][2];
#pragma unroll
        for (int bj = 0; bj < 2; ++bj)
#pragma unroll
            for (int n = 0; n < 2; ++n) { g[bj][n] = (f32x4){1.f, 1.f, 1.f, 1.f};
                if (qk) { g[bj][n] = *(const f32x4*)((isq ? qg : kg) + 32 * bj + 8 * fq + 4 * n); if (isq) g[bj][n] = g[bj][n] * QC2; } }
#pragma unroll
        for (int ai = 0; ai < 2; ++ai)
#pragma unroll
            for (int m = 0; m < 4; ++m) { const int row = row0 + ai * HALF + m * 16;
                const float rs = rsv[ai][m];
                f32x4 v[2][2];
#pragma unroll
                for (int bj = 0; bj < 2; ++bj)
#pragma unroll
                    for (int n = 0; n < 2; ++n) v[bj][n] = acc[ai][bj][m][n] * rs;
                if (qk) { float s = 0.f;
#pragma unroll
                    for (int bj = 0; bj < 2; ++bj)
#pragma unroll
                        for (int n = 0; n < 2; ++n) { const f32x4 x = v[bj][n]; s += (x[0] * x[0] + x[1] * x[1]) + (x[2] * x[2] + x[3] * x[3]); }
                    s += __shfl_xor(s, 16); s += __shfl_xor(s, 32);
                    const float r = 1.0f / sqrtf(s * (1.0f / 64.0f) + RMS_EPS);
#pragma unroll
                    for (int bj = 0; bj < 2; ++bj)
#pragma unroll
                        for (int n = 0; n < 2; ++n) v[bj][n] = v[bj][n] * r * g[bj][n]; }
                if (u.pn >= 16) {
                    const f32x4 q0 = v[0][0] * v[1][0], q1 = v[0][1] * v[1][1];
                    u32x4 w; w.x = cvt_pk_bf16(q0[0], q0[1]); w.y = cvt_pk_bf16(q0[2], q0[3]); w.z = cvt_pk_bf16(q1[0], q1[1]); w.w = cvt_pk_bf16(q1[2], q1[3]);
                    *(u32x4*)(O + (size_t)row * ldc + 4096 + (u.pn - 16) * 128 + wc * 32 + 8 * fq) = w;
                } else {
                bf16_t* rowp = O + (size_t)row * ldc + col0;
                if (u.pn >= 4 && u.pn < 12) { const int c = (u.pn & 3) * 256 + wc * 64 + 8 * fq; rowp = (u.pn < 8 ? KH : VH) + ((size_t)((row >> 11) * 8 + (c >> 7)) * 2048 + (row & 2047)) * 128 + (c & 127); }
#pragma unroll
                for (int bj = 0; bj < 2; ++bj) { u32x4 w; w.x = cvt_pk_bf16(v[bj][0][0], v[bj][0][1]); w.y = cvt_pk_bf16(v[bj][0][2], v[bj][0][3]); w.z = cvt_pk_bf16(v[bj][1][0], v[bj][1][1]); w.w = cvt_pk_bf16(v[bj][1][2], v[bj][1][3]);
                    *(u32x4*)(rowp + 32 * bj) = w; } } }
    }
};
struct EpiUp {
    typedef RsState State; static constexpr int KR = 1;
    static constexpr bool PERM = true, AFTER_DRAIN = false;
    bf16_t* O; const float* ssq; int ldc;
    __device__ __forceinline__ void init(f32x4 (&acc)[2][2][4][2], State& st, const Unit& u, int wr, int, int fr, int fq) const { zero_acc(acc);
        if (st.pm != u.pm) { float t[2][4]; rows_rstd(t, ssq, u.pm * BM + wr * 64 + fr, fq); st.ra = (f32x4){t[0][0], t[0][1], t[0][2], t[0][3]}; st.rb = (f32x4){t[1][0], t[1][1], t[1][2], t[1][3]}; st.pm = u.pm; } }
    __device__ __forceinline__ void operator()(const f32x4 (&acc)[2][2][4][2], const State& st, const Unit& u, int wr, int wc, int fr, int fq) const {
        const int row0 = u.pm * BM + wr * 64 + fr, col0 = u.pn * BM + wc * 32 + 8 * fq;
        const float rsv[2][4] = {{st.ra[0], st.ra[1], st.ra[2], st.ra[3]}, {st.rb[0], st.rb[1], st.rb[2], st.rb[3]}};
#pragma unroll
        for (int ai = 0; ai < 2; ++ai)
#pragma unroll
            for (int m = 0; m < 4; ++m) { const int row = row0 + ai * HALF + m * 16;
                const float rs = rsv[ai][m];
                bf16_t* rowp = O + ((size_t)(row >> 8) * (ldc >> 6) * 256 + (row & 255)) * 64;
#pragma unroll
                for (int bj = 0; bj < 2; ++bj) { f32x4 v0 = acc[ai][bj][m][0] * rs, v1 = acc[ai][bj][m][1] * rs;
#pragma unroll
                    for (int e = 0; e < 4; ++e) { const float a = fmaxf(v0[e], 0.f), b = fmaxf(v1[e], 0.f); v0[e] = a * a; v1[e] = b * b; }
                    u32x4 w; w.x = cvt_pk_bf16(v0[0], v0[1]); w.y = cvt_pk_bf16(v0[2], v0[3]); w.z = cvt_pk_bf16(v1[0], v1[1]); w.w = cvt_pk_bf16(v1[2], v1[3]);
                    { const int col = col0 + bj * HALF; *(u32x4*)(rowp + (size_t)(col >> 6) * (256 * 64) + (col & 63)) = w; } } }
    }
};
struct EpiResid {
    typedef NoState State; static constexpr int KR = 1;
    static constexpr bool PERM = true, AFTER_DRAIN = false;
    const float* xin_f; float* xout_f; bf16_t* xb; float* ssq; int ldc;
    __device__ __forceinline__ size_t xb_off(int row, int col) const { return ((size_t)(row >> 8) * (ldc >> 6) + (col >> 6)) * (256 * 64) + (size_t)(row & 255) * 64 + (col & 63); }
    __device__ __forceinline__ void init(f32x4 (&acc)[2][2][4][2], State&, const Unit& u, int wr, int wc, int fr, int fq) const {
        const int row0 = u.pm * BM + wr * 64 + fr, col0 = u.pn * BM + wc * 32 + 8 * fq;
        if (xin_f) {
#pragma unroll
            for (int ai = 0; ai < 2; ++ai)
#pragma unroll
                for (int m = 0; m < 4; ++m) { const size_t off = (size_t)(row0 + ai * HALF + m * 16) * ldc + col0;
#pragma unroll
                    for (int bj = 0; bj < 2; ++bj)
#pragma unroll
                        for (int n = 0; n < 2; ++n) acc[ai][bj][m][n] = *(const f32x4*)(xin_f + off + bj * HALF + n * 4); }
        } else {
#pragma unroll
            for (int ai = 0; ai < 2; ++ai)
#pragma unroll
                for (int m = 0; m < 4; ++m) { const size_t off = (size_t)(row0 + ai * HALF + m * 16) * ldc + col0;
#pragma unroll
                    for (int bj = 0; bj < 2; ++bj) { const u32x4 w = *(const u32x4*)(xb + xb_off(row0 + ai * HALF + m * 16, col0 + bj * HALF));
                        acc[ai][bj][m][0] = (f32x4){__uint_as_float(w.x << 16), __uint_as_float(w.x & 0xffff0000u), __uint_as_float(w.y << 16), __uint_as_float(w.y & 0xffff0000u)};
                        acc[ai][bj][m][1] = (f32x4){__uint_as_float(w.z << 16), __uint_as_float(w.z & 0xffff0000u), __uint_as_float(w.w << 16), __uint_as_float(w.w & 0xffff0000u)}; } }
        }
    }
    __device__ __forceinline__ void operator()(const f32x4 (&acc)[2][2][4][2], const State&, const Unit& u, int wr, int wc, int fr, int fq) const {
        const int row0 = u.pm * BM + wr * 64 + fr, col0 = u.pn * BM + wc * 32 + 8 * fq;
        if (xout_f) {
#pragma unroll
            for (int ai = 0; ai < 2; ++ai)
#pragma unroll
                for (int m = 0; m < 4; ++m) { const size_t off = (size_t)(row0 + ai * HALF + m * 16) * ldc + col0;
#pragma unroll
                    for (int bj = 0; bj < 2; ++bj)
#pragma unroll
                        for (int n = 0; n < 2; ++n) *(f32x4*)(xout_f + off + bj * HALF + n * 4) = acc[ai][bj][m][n]; }
        } else {
#pragma unroll
            for (int ai = 0; ai < 2; ++ai)
#pragma unroll
                for (int m = 0; m < 4; ++m) { const int row = row0 + ai * HALF + m * 16; const size_t off = (size_t)row * ldc + col0; float ss = 0.f;
#pragma unroll
                    for (int bj = 0; bj < 2; ++bj) { const f32x4 v0 = acc[ai][bj][m][0], v1 = acc[ai][bj][m][1];
                        u32x4 w; w.x = cvt_pk_bf16(v0[0], v0[1]); w.y = cvt_pk_bf16(v0[2], v0[3]); w.z = cvt_pk_bf16(v1[0], v1[1]); w.w = cvt_pk_bf16(v1[2], v1[3]);
                        *(u32x4*)(xb + xb_off(row, col0 + bj * HALF)) = w;
                        ss += ((v0[0] * v0[0] + v0[1] * v0[1]) + (v0[2] * v0[2] + v0[3] * v0[3])) + ((v1[0] * v1[0] + v1[1] * v1[1]) + (v1[2] * v1[2] + v1[3] * v1[3])); }
                    ss += __shfl_xor(ss, 16); ss += __shfl_xor(ss, 32);
                    if (fq == 0) ssq[(size_t)row * 32 + u.pn * 4 + wc] = ss; }
        }
    }
};
#ifndef KREP
#define KREP 1
#endif
template <class Epi, class Sched, bool ALIGN_EPI = false, bool SP2 = false>
__device__ __forceinline__ void gemm_phase(PG8_LAS unsigned char* lds, const Gemm g, const Sched& S, const Epi& E) {
    int tid_ = threadIdx.x; asm volatile("" : "+v"(tid_));
    const int tid = tid_, wid = __builtin_amdgcn_readfirstlane(tid >> 6), lane = tid & 63, wr = wid >> 2, wc = wid & 3, fr = lane & 15, fq = lane >> 4;
    const int K = g.K, nt = K / BK;
    constexpr int KR = (KREP == 2) ? 2 : Epi::KR;
    const int Ka = g.a_blocked ? BK : g.K;
    unsigned voffA[2], voffB[2];
#pragma unroll
    for (int i = 0; i < 2; ++i) { int R, C; stage_rc(tid * 16 + i * 8192, R, C); const int Rb = Epi::PERM ? ((R & ~31) + perm32(R & 31)) : R;
        voffA[i] = (unsigned)(R * Ka + C) * 2u; voffB[i] = (unsigned)(Rb * BK + C) * 2u; }
    const size_t kstep = (size_t)(BK * 2);
    const size_t hstep = (size_t)HALF * K * 2;
    const size_t kstepB = (size_t)(BM * BK * 2), hstepB = (size_t)(HALF * BK * 2);
    const size_t kstepA = g.a_blocked ? (size_t)(BM * BK * 2) : kstep, hstepA = g.a_blocked ? (size_t)(HALF * BK * 2) : hstep;
    const size_t tstep = 2 * hstep;
    const unsigned ldsw = (unsigned)wid * 1024u;
    const int aoff = lds_byte(wr * 64 + fr, fq * 8), boff = lds_byte(wc * 32 + fr, fq * 8);
#define PG8_SA(b, h) (((b) * 2 + (h)) * HTB)
#define PG8_SB(b, h) ((4 + (b) * 2 + (h)) * HTB)
#define PG8_STAGE(bufoff, gbase, voff) do { _Pragma("unroll") for (int _i = 0; _i < 2; ++_i) \
        __builtin_amdgcn_global_load_lds((const unsigned*)((const char*)(gbase) + (voff)[_i]), (PG8_LAS unsigned*)(lds + (bufoff) + ldsw + _i * 8192), 16, 0, 0); } while (0)
#define PG8_LDA(dst, b, h) do { _Pragma("unroll") for (int m = 0; m < 4; ++m) _Pragma("unroll") for (int k = 0; k < 2; ++k) dst[m][k] = *(const PG8_LAS bf16x8*)(lds + PG8_SA(b, h) + aoff + m * 2048 + k * 1024); } while (0)
#define PG8_LDB(dst, b, h) do { _Pragma("unroll") for (int n = 0; n < 2; ++n) _Pragma("unroll") for (int k = 0; k < 2; ++k) dst[n][k] = *(const PG8_LAS bf16x8*)(lds + PG8_SB(b, h) + boff + n * 2048 + k * 1024); } while (0)
#define PG8_MMA(ai, bj, At, Bt) do { __builtin_amdgcn_s_setprio(1); _Pragma("unroll") for (int m = 0; m < 4; ++m) _Pragma("unroll") for (int n = 0; n < 2; ++n) _Pragma("unroll") for (int k = 0; k < 2; ++k) \
        acc[ai][bj][m][n] = __builtin_amdgcn_mfma_f32_16x16x32_bf16(Bt[n][k], At[m][k], acc[ai][bj][m][n], 0, 0, 0); __builtin_amdgcn_s_setprio(0); } while (0)
#define PG8_WAIT_V(n) asm volatile("s_waitcnt vmcnt(" #n ")" ::: "memory")
#define PG8_WAIT_L(n) asm volatile("s_waitcnt lgkmcnt(" #n ")" ::: "memory")
#define PG8_BAR __builtin_amdgcn_s_barrier()
#define PG8_SCHED __builtin_amdgcn_sched_barrier(0)
    Unit cur, nxt; int ui = 0;
    if (!S.next(0, cur)) return;
    f32x4 acc[2][2][4][2];
    typename Epi::State est; est.pm = -1;
    E.init(acc, est, cur, wr, wc, fr, fq);
    bf16x8 At[4][2], B0[2][2], B1[2][2];
    const char* cA = (const char*)g.A + (size_t)cur.pm * tstep; const char* cB = (const char*)g.Bt + (size_t)cur.pn * tstep;
    S.a_ready(cur);
    if constexpr (SP2) {
        PG8_STAGE(PG8_SB(0, 0), cB, voffB); PG8_STAGE(PG8_SB(0, 1), cB + hstepB, voffB); PG8_STAGE(PG8_SA(0, 0), cA, voffA); PG8_STAGE(PG8_SA(0, 1), cA + hstepA, voffA);
        if (wr == 1) PG8_BAR;
        PG8_WAIT_V(2); PG8_BAR;
        PG8_STAGE(PG8_SB(1, 0), cB + kstepB, voffB); PG8_STAGE(PG8_SA(1, 0), cA + kstepA, voffA); PG8_STAGE(PG8_SB(1, 1), cB + hstepB + kstepB, voffB);
        PG8_WAIT_V(6); PG8_BAR;
    } else {
        PG8_STAGE(PG8_SB(0, 0), cB, voffB); PG8_STAGE(PG8_SA(0, 0), cA, voffA); PG8_STAGE(PG8_SB(0, 1), cB + hstepB, voffB); PG8_STAGE(PG8_SA(0, 1), cA + hstepA, voffA);
        if (wr == 1) PG8_BAR;
        PG8_WAIT_V(4); PG8_BAR;
        PG8_STAGE(PG8_SB(1, 0), cB + kstepB, voffB); PG8_STAGE(PG8_SA(1, 0), cA + kstepA, voffA); PG8_STAGE(PG8_SB(1, 1), cB + hstepB + kstepB, voffB);
        PG8_WAIT_V(6); PG8_BAR;
    }
    for (;;) {
        const bool has_next = S.next(ui + 1, nxt);
        const char* nA = has_next ? (const char*)g.A + (size_t)nxt.pm * tstep : cA; const char* nB = has_next ? (const char*)g.Bt + (size_t)nxt.pn * tstep : cB;
        for (int t0_ = 0; t0_ < KR * nt; t0_ += 2) {
            const bool last = (t0_ == KR * nt - 2); const int t = (KR == 1) ? t0_ : (t0_ % nt), t2_ = (KR == 1) ? t0_ + 2 : ((t0_ + 2) % nt);
            const char* a1 = cA + (size_t)(t + 1) * kstepA;
            const char* a2 = last ? nA : cA + (size_t)t2_ * kstepA; const char* b2 = last ? nB : cB + (size_t)t2_ * kstepB;
            const char* a3 = a2 + kstepA; const char* b3 = b2 + kstepB;
            if (last && has_next) S.a_ready(nxt);
            if constexpr (SP2) {
            PG8_LDB(B0, 0, 0); PG8_LDB(B1, 0, 1); PG8_SCHED; PG8_LDA(At, 0, 0); PG8_STAGE(PG8_SA(1, 1), a1 + hstepA, voffA);
            PG8_WAIT_V(8); PG8_WAIT_L(0); PG8_BAR; PG8_MMA(0, 0, At, B0); PG8_MMA(0, 1, At, B1); PG8_BAR; PG8_SCHED;
            PG8_LDA(At, 0, 1); PG8_STAGE(PG8_SB(0, 0), b2, voffB); PG8_STAGE(PG8_SB(0, 1), b2 + hstepB, voffB); PG8_STAGE(PG8_SA(0, 0), a2, voffA);
            PG8_WAIT_V(8); PG8_WAIT_L(0); PG8_BAR; PG8_MMA(1, 0, At, B0); PG8_MMA(1, 1, At, B1); PG8_BAR; PG8_SCHED;
            PG8_LDB(B0, 1, 0); PG8_LDB(B1, 1, 1); PG8_SCHED; PG8_LDA(At, 1, 0); PG8_STAGE(PG8_SA(0, 1), a2 + hstepA, voffA);
            PG8_WAIT_V(8); PG8_WAIT_L(0); PG8_BAR; PG8_MMA(0, 0, At, B0); PG8_MMA(0, 1, At, B1); PG8_BAR; PG8_SCHED;
            PG8_LDA(At, 1, 1); PG8_STAGE(PG8_SB(1, 0), b3, voffB); PG8_STAGE(PG8_SB(1, 1), b3 + hstepB, voffB); PG8_STAGE(PG8_SA(1, 0), a3, voffA);
            PG8_WAIT_V(8); PG8_WAIT_L(0); PG8_BAR; PG8_MMA(1, 0, At, B0); PG8_MMA(1, 1, At, B1); PG8_BAR; PG8_SCHED;
            } else {
            PG8_LDB(B0, 0, 0); PG8_SCHED; PG8_LDA(At, 0, 0); PG8_STAGE(PG8_SA(1, 1), a1 + hstepA, voffA);
            PG8_WAIT_L(8); PG8_BAR; PG8_WAIT_L(0); PG8_MMA(0, 0, At, B0); PG8_BAR; PG8_SCHED;
            PG8_LDB(B1, 0, 1); PG8_STAGE(PG8_SB(0, 0), b2, voffB);
            PG8_BAR; PG8_WAIT_L(0); PG8_MMA(0, 1, At, B1); PG8_BAR;
            PG8_LDA(At, 0, 1); PG8_STAGE(PG8_SA(0, 0), a2, voffA);
            PG8_BAR; PG8_WAIT_L(0); PG8_MMA(1, 0, At, B0); PG8_BAR; PG8_SCHED;
            PG8_STAGE(PG8_SB(0, 1), b2 + hstepB, voffB);
            PG8_WAIT_V(6); PG8_BAR; PG8_MMA(1, 1, At, B1); PG8_BAR;
            PG8_LDB(B0, 1, 0); PG8_SCHED; PG8_LDA(At, 1, 0); PG8_STAGE(PG8_SA(0, 1), a2 + hstepA, voffA);
            PG8_WAIT_L(8); PG8_BAR; PG8_WAIT_L(0); PG8_MMA(0, 0, At, B0); PG8_BAR; PG8_SCHED;
            PG8_LDB(B1, 1, 1); PG8_STAGE(PG8_SB(1, 0), b3, voffB);
            PG8_BAR; PG8_WAIT_L(0); PG8_MMA(0, 1, At, B1); PG8_BAR;
            PG8_LDA(At, 1, 1); PG8_STAGE(PG8_SA(1, 0), a3, voffA);
            PG8_BAR; PG8_WAIT_L(0); PG8_MMA(1, 0, At, B0); PG8_BAR; PG8_SCHED;
            PG8_STAGE(PG8_SB(1, 1), b3 + hstepB, voffB);
            PG8_WAIT_V(6); PG8_BAR; PG8_MMA(1, 1, At, B1); PG8_BAR;
            }
        }
        if constexpr (KR == 2) {
#pragma unroll
            for (int a = 0; a < 2; ++a)
#pragma unroll
                for (int b = 0; b < 2; ++b)
#pragma unroll
                    for (int m = 0; m < 4; ++m)
#pragma unroll
                        for (int n = 0; n < 2; ++n) acc[a][b][m][n] = acc[a][b][m][n] * 0.5f;
        }
        if constexpr (ALIGN_EPI) { if (wr == 0) PG8_BAR; }
        if constexpr (!Epi::AFTER_DRAIN) { E(acc, est, cur, wr, wc, fr, fq); S.done(cur); }
        if (!has_next) break;
        E.init(acc, est, nxt, wr, wc, fr, fq);
        cur = nxt; cA = nA; cB = nB; ++ui;
        if constexpr (ALIGN_EPI) { if (wr == 1) PG8_BAR; }
    }
    PG8_WAIT_V(0);
    if constexpr (!ALIGN_EPI) { if (wr == 0) PG8_BAR; }
    PG8_BAR;
    if constexpr (Epi::AFTER_DRAIN) { E.fused(acc, cur, wr, wc, fr, fq, lds, wid, lane); S.done(cur); }
#undef PG8_SA
#undef PG8_SB
#undef PG8_STAGE
#undef PG8_LDA
#undef PG8_LDB
#undef PG8_MMA
#undef PG8_WAIT_V
#undef PG8_WAIT_L
#undef PG8_BAR
#undef PG8_SCHED
}
}
namespace att {
using bf16 = __hip_bfloat16;
using bf16x8 = __attribute__((ext_vector_type(8))) short;
using s16x4 = __attribute__((ext_vector_type(4))) short;
using f32x16 = __attribute__((ext_vector_type(16))) float;
using u32x4 = __attribute__((ext_vector_type(4))) unsigned;
constexpr int SEQ = 2048, PW = 6144, DMODEL = 2048, KVBLK = 64, QB = 128;
constexpr int SHM_V = KVBLK * 128 * 2, SHM_K = KVBLK * 128 * 2;
constexpr int NSLOT = 3, SLOTB = SHM_K + SHM_V;
constexpr int LDS_WS = NSLOT * SLOTB, LDS_BT = LDS_WS + 8 * 64 * 4, LDS_END = LDS_BT + 2 * 384 * 4;
constexpr float THR2 = 8.0f;
#define KSWZ(row, colB) ((row) * 256 + ((colB) ^ (((row) & 7) << 4)))
#define SBAR() __builtin_amdgcn_sched_barrier(0)
__device__ __forceinline__ int crow(int r, int hi) { return (r & 3) + 8 * (r >> 2) + 4 * hi; }
__device__ __forceinline__ unsigned cvtpk(float lo, float hi) { unsigned r; asm volatile("v_cvt_pk_bf16_f32 %0, %1, %2" : "=v"(r) : "v"(lo), "v"(hi)); return r; }
__device__ __forceinline__ void partialSM(f32x16& p0, f32x16& p1, float& m_reg, float& alpha, float cadd) {
  float pmax = p0[0];
#pragma unroll
  for (int r = 1; r < 16; ++r) pmax = fmaxf(pmax, p0[r]);
#pragma unroll
  for (int r = 0; r < 16; ++r) pmax = fmaxf(pmax, p1[r]);
  { auto rr = __builtin_amdgcn_permlane32_swap(__float_as_uint(pmax), __float_as_uint(pmax), false, false);
    pmax = fmaxf(__uint_as_float(rr[0]), __uint_as_float(rr[1])) + cadd; }
  if (__builtin_expect(__all(pmax - m_reg <= THR2), 1)) { alpha = 1.f; }
  else { const float mn = fmaxf(m_reg, pmax); alpha = __builtin_amdgcn_exp2f(m_reg - mn); m_reg = mn; }
  const float sh = cadd - m_reg;
#pragma unroll
  for (int r = 0; r < 16; ++r) { p0[r] += sh; p1[r] += sh; }
#pragma unroll
  for (int r = 0; r < 16; ++r) p0[r] = __builtin_amdgcn_exp2f(p0[r]);
}
__device__ __forceinline__ void finishSM(f32x16& p0, f32x16& p1, float alpha, float& l_reg, bf16x8& pa0, bf16x8& pa1, bf16x8& pa2, bf16x8& pa3) {
#pragma unroll
  for (int r = 0; r < 16; ++r) p1[r] = __builtin_amdgcn_exp2f(p1[r]);
  float ps = 0;
#pragma unroll
  for (int r = 0; r < 16; ++r) ps += p0[r];
#pragma unroll
  for (int r = 0; r < 16; ++r) ps += p1[r];
  { auto rr = __builtin_amdgcn_permlane32_swap(__float_as_uint(ps), __float_as_uint(ps), false, false);
    ps = __uint_as_float(rr[0]) + __uint_as_float(rr[1]); }
  l_reg = l_reg * alpha + ps;
#define PK4(P, BASE, OUT) do { unsigned a0 = cvtpk(P[BASE + 0], P[BASE + 1]), a1 = cvtpk(P[BASE + 2], P[BASE + 3]);   \
    unsigned b0 = cvtpk(P[BASE + 4], P[BASE + 5]), b1 = cvtpk(P[BASE + 6], P[BASE + 7]);                              \
    auto r0 = __builtin_amdgcn_permlane32_swap(a0, b0, false, false); auto r1 = __builtin_amdgcn_permlane32_swap(a1, b1, false, false); \
    u32x4 w = {r0[0], r1[0], r0[1], r1[1]}; OUT = *reinterpret_cast<bf16x8*>(&w); } while (0)
  PK4(p0, 0, pa0); PK4(p0, 8, pa1); PK4(p1, 0, pa2); PK4(p1, 8, pa3);
#undef PK4
}
__device__ __forceinline__ void qkt(f32x16& p0, f32x16& p1, const char* Ks, const bf16x8* qr, int r32, int hi, int m, const f32x16& cinit) {
  bf16x8 kf[8];
#pragma unroll
  for (int d0 = 0; d0 < 4; ++d0) { const int cb = (m * 64 + d0 * 16 + hi * 8) * 2;
    kf[2 * d0] = *reinterpret_cast<const bf16x8*>(Ks + KSWZ(r32, cb)); kf[2 * d0 + 1] = *reinterpret_cast<const bf16x8*>(Ks + KSWZ(32 + r32, cb)); }
  SBAR();
  p0 = __builtin_amdgcn_mfma_f32_32x32x16_bf16(kf[0], qr[0], cinit, 0, 0, 0);
  p1 = __builtin_amdgcn_mfma_f32_32x32x16_bf16(kf[1], qr[0], cinit, 0, 0, 0);
#pragma unroll
  for (int d0 = 1; d0 < 4; ++d0) {
    p0 = __builtin_amdgcn_mfma_f32_32x32x16_bf16(kf[2 * d0], qr[d0], p0, 0, 0, 0);
    p1 = __builtin_amdgcn_mfma_f32_32x32x16_bf16(kf[2 * d0 + 1], qr[d0], p1, 0, 0, 0); }
  SBAR();
}
__device__ __forceinline__ void bias_mask(f32x16& p0, f32x16& p1, const float* bt, int base) {
#pragma unroll
  for (int r = 0; r < 16; ++r) { const int c = (r & 3) + 8 * (r >> 2); p0[r] += bt[base - c]; }
  SBAR();
#pragma unroll
  for (int r = 0; r < 16; ++r) { const int c = (r & 3) + 8 * (r >> 2); p1[r] += bt[base - c - 32]; }
}
__device__ __forceinline__ int v_st(int k, int c) { const int kk = (k & ~0xC) | ((k & 4) << 1) | ((k & 8) >> 1); return ((kk >> 3) * 4 + (c >> 5)) * 512 + ((kk & 7) * 32 + (c & 31)) * 2; }
__device__ __forceinline__ int v_rd_base(int lane) { return ((lane & 3) << 3) | (((lane >> 2) & 3) << 6) | (((lane >> 4) & 1) << 5) | (((lane >> 5) & 1) << 8); }
constexpr int v_rd_off(int d0, int ks, int half) { return d0 * 512 + ks * 4096 + half * 2048; }
typedef short v4i16_t __attribute__((ext_vector_type(4)));
typedef __attribute__((address_space(3))) const char* lds_cptr;
__device__ __forceinline__ s16x4 vtr(lds_cptr p) { return __builtin_bit_cast(s16x4, __builtin_amdgcn_ds_read_tr16_b64_v4i16((__attribute__((address_space(3))) v4i16_t*)p)); }
struct VFrag { s16x4 lo[4], hi[4]; };
template <int KS> __device__ __forceinline__ void v_read(VFrag& f, lds_cptr vp) {
#pragma unroll
  for (int d0 = 0; d0 < 4; ++d0) { f.lo[d0] = vtr(vp + v_rd_off(d0, KS, 0)); f.hi[d0] = vtr(vp + v_rd_off(d0, KS, 1)); }
}
__device__ __forceinline__ void pv_slice(f32x16* o, const VFrag& f, bf16x8 pa) {
#pragma unroll
  for (int d0 = 0; d0 < 4; ++d0) { const bf16x8 vf = (bf16x8){f.lo[d0][0], f.lo[d0][1], f.lo[d0][2], f.lo[d0][3], f.hi[d0][0], f.hi[d0][1], f.hi[d0][2], f.hi[d0][3]};
    o[d0] = __builtin_amdgcn_mfma_f32_32x32x16_bf16(pa, vf, o[d0], 0, 0, 0); }
}
__device__ __forceinline__ void pv_all(f32x16* o, lds_cptr vp, bf16x8 pa0, bf16x8 pa1, bf16x8 pa2, bf16x8 pa3) {
  VFrag fa, fb;
  v_read<0>(fa, vp); v_read<1>(fb, vp); SBAR();
  pv_slice(o, fa, pa0); SBAR(); v_read<2>(fa, vp); SBAR();
  pv_slice(o, fb, pa1); SBAR(); v_read<3>(fb, vp); SBAR();
  pv_slice(o, fa, pa2); SBAR();
  pv_slice(o, fb, pa3); SBAR();
}
__device__ __forceinline__ void conv_item(const bf16* __restrict__ P, bf16* __restrict__ MIX, const float* __restrict__ cw, int it, int lane) {
  const unsigned short* Pu = reinterpret_cast<const unsigned short*>(P); unsigned short* Mu = reinterpret_cast<unsigned short*>(MIX);
  const int t0 = it * 4; const bool first = (t0 % SEQ) == 0;
#pragma unroll
  for (int j = 0; j < 2; ++j) { const int c0 = j * 512 + lane * 8;
    float w0[8], w1[8], w2[8];
#pragma unroll
    for (int e = 0; e < 8; ++e) { w0[e] = cw[c0 + e]; w1[e] = cw[1024 + c0 + e]; w2[e] = cw[2048 + c0 + e]; }
    float p[6][8];
#pragma unroll
    for (int k = 0; k < 6; ++k) { const int t = t0 - 2 + k;
      if (k < 2 && first) {
#pragma unroll
        for (int e = 0; e < 8; ++e) p[k][e] = 0.f;
      } else { const u32x4 gp = *(const u32x4*)(Pu + (size_t)t * PW + 4096 + c0);
#pragma unroll
        for (int e = 0; e < 4; ++e) { p[k][2 * e] = __uint_as_float(gp[e] << 16); p[k][2 * e + 1] = __uint_as_float(gp[e] & 0xffff0000u); } } }
#pragma unroll
    for (int i = 0; i < 4; ++i) { const u32x4 gb = *(const u32x4*)(Pu + (size_t)(t0 + i) * PW + 3072 + c0); float r[8];
#pragma unroll
      for (int e = 0; e < 4; ++e) { r[2 * e] = __uint_as_float(gb[e] << 16) * (w0[2 * e] * p[i][2 * e] + w1[2 * e] * p[i + 1][2 * e] + w2[2 * e] * p[i + 2][2 * e]);
        r[2 * e + 1] = __uint_as_float(gb[e] & 0xffff0000u) * (w0[2 * e + 1] * p[i][2 * e + 1] + w1[2 * e + 1] * p[i + 1][2 * e + 1] + w2[2 * e + 1] * p[i + 2][2 * e + 1]); }
      u32x4 o; o.x = cvtpk(r[0], r[1]); o.y = cvtpk(r[2], r[3]); o.z = cvtpk(r[4], r[5]); o.w = cvtpk(r[6], r[7]);
      *(u32x4*)(Mu + (size_t)(t0 + i) * DMODEL + 1024 + c0) = o; } }
}
template <bool FIXED> __device__ __forceinline__ void attn_unit(int b, int h, int qb, const bf16* __restrict__ P, const bf16* __restrict__ KHp, const bf16* __restrict__ VHp, bf16* __restrict__ MIX, const float* __restrict__ BT, const float* __restrict__ subg,
                                          float lam, float post, float sref, const float* __restrict__ cw, int conv_base, char* lds) {
  int tid_ = threadIdx.x; asm volatile("" : "+v"(tid_));
  const int tid = tid_, lane = tid & 63, r32 = lane & 31, hi = lane >> 5;
  const int wid = __builtin_amdgcn_readfirstlane(tid >> 6), m = wid >> 2, wq = wid & 3;
  const long rowbase = (long)b * SEQ; const int q0 = qb * QB, qw0 = q0 + wq * 32;
  float* ws = (float*)(lds + LDS_WS) + wid * 64; float* li_l = ws; float* al_l = ws + 32;
  float* btl = (float*)(lds + LDS_BT);
  for (int i = tid; i < 768; i += 512) btl[i] = BT[(size_t)h * 768 + i] - (FIXED ? sref : 0.f);
  const float* bt = btl + m * 384 + 128;
  const float c31 = BT[(size_t)h * 768 + m * 384 + 128 + 127] - (FIXED ? sref : 0.f);
  f32x16 cfar, czero = f32x16{};
#pragma unroll
  for (int r = 0; r < 16; ++r) cfar[r] = FIXED ? c31 : 0.f;
  float m_reg = -1e30f, l_reg = 0.f; f32x16 o[4] = {}; bf16x8 qr[4];
  const bf16* Qw = P + (rowbase + qw0 + r32) * PW + h * 128 + m * 64 + hi * 8;
#pragma unroll
  for (int d0 = 0; d0 < 4; ++d0) qr[d0] = *reinterpret_cast<const bf16x8*>(Qw + d0 * 16);
  const bf16* Kh = KHp + (size_t)(b * 8 + h) * SEQ * 128; const bf16* Vh = VHp + (size_t)(b * 8 + h) * SEQ * 128;
  unsigned ksrc[2], vsrc[2];
#pragma unroll
  for (int i = 0; i < 2; ++i) { const int pk = wid * 2 + i;
    { const int row = 4 * pk + (lane >> 4), cc = lane & 15; ksrc[i] = (unsigned)(row * 128 + ((cc ^ (row & 7)) * 8)); }
    { const int ob = pk * 1024 + lane * 16, sub = ob >> 9, kk = (sub >> 2) * 8 + ((ob & 511) >> 6), k = (kk & ~0xC) | ((kk & 4) << 1) | ((kk & 8) >> 1), c = (sub & 3) * 32 + ((ob & 63) >> 1);
      vsrc[i] = (unsigned)(k * 128 + c); } }
  typedef __attribute__((address_space(3))) unsigned lds_u32;
  typedef __attribute__((address_space(3))) unsigned char lds_u8;
  lds_u8* const ring = (lds_u8*)lds + wid * 2048;
#define DMA_TILE(t, slot) do { const bf16* kg_ = Kh + (long)(t) * KVBLK * 128; const bf16* vg_ = Vh + (long)(t) * KVBLK * 128; \
    _Pragma("unroll") for (int i_ = 0; i_ < 2; ++i_) { \
      __builtin_amdgcn_global_load_lds((const unsigned*)(kg_ + ksrc[i_]), (lds_u32*)(ring + (slot) * SLOTB + i_ * 1024), 16, 0, 0); \
      __builtin_amdgcn_global_load_lds((const unsigned*)(vg_ + vsrc[i_]), (lds_u32*)(ring + (slot) * SLOTB + SHM_K + i_ * 1024), 16, 0, 0); } } while (0)
#define WAIT_BAR(N) asm volatile("s_waitcnt vmcnt(" #N ") lgkmcnt(0)\n\ts_barrier" ::: "memory")
  const lds_cptr vp0 = (lds_cptr)lds + SHM_K + v_rd_base(lane);
#define RESC(a) do { if (__any((a) < 1.f)) { if (hi == 0) al_l[r32] = (a); asm volatile("s_waitcnt lgkmcnt(0)" ::: "memory"); \
    _Pragma("unroll") for (int d = 0; d < 4; ++d) _Pragma("unroll") for (int r = 0; r < 16; ++r) o[d][r] *= al_l[crow(r, hi)]; } } while (0)
#define SCORE(P0, P1, Kbuf, t, CADD) do { const int dmin_ = qw0 - 64 * (t) - 63; const bool far_ = dmin_ >= 113; CADD = (far_ && !FIXED) ? c31 : 0.f; \
    if (FIXED && far_) { qkt(P0, P1, Kbuf, qr, r32, hi, m, cfar); } \
    else { qkt(P0, P1, Kbuf, qr, r32, hi, m, czero); if (!far_) bias_mask(P0, P1, bt, qw0 + r32 - 64 * (t) - 4 * hi); } } while (0)
  f32x16 p0, p1; float al, ca; bf16x8 pa0, pa1, pa2, pa3; const int NT = 2 * qb + 2;
#ifndef ATT_REP
#define ATT_REP 1
#endif
  const int NTT = ATT_REP * NT;
  DMA_TILE(0, 0); DMA_TILE(1, 1);
  WAIT_BAR(4);
  int slot = 0;
  for (int tt = 0; tt < NTT; ++tt) {
    const int t = (ATT_REP == 1) ? tt : (tt % NT), t2 = (ATT_REP == 1) ? tt + 2 : ((tt + 2) % NT);
    const int s2 = (slot >= 1) ? slot - 1 : 2;
    if (tt + 2 < NTT) DMA_TILE(t2, s2);
    SBAR();
#ifndef ATT_CREP
#define ATT_CREP 1
#endif
#pragma unroll 1
    for (int crep = 0; crep < ATT_CREP; ++crep) {
    SCORE(p0, p1, lds + slot * SLOTB, t, ca);
    if constexpr (FIXED) {
#pragma unroll
      for (int r = 0; r < 16; ++r) p0[r] = __builtin_amdgcn_exp2f(p0[r]);
      finishSM(p0, p1, 1.f, l_reg, pa0, pa1, pa2, pa3); SBAR();
    } else {
      partialSM(p0, p1, m_reg, al, ca);
      RESC(al);
      finishSM(p0, p1, al, l_reg, pa0, pa1, pa2, pa3); SBAR();
    }
    pv_all(o, vp0 + slot * SLOTB, pa0, pa1, pa2, pa3);
    }
    if (tt + 2 < NTT) WAIT_BAR(4); else WAIT_BAR(0);
    slot = (slot == 2) ? 0 : slot + 1;
  }
  if (hi == 0) li_l[r32] = l_reg; asm volatile("s_waitcnt lgkmcnt(0)" ::: "memory");
  float rli[16];
#pragma unroll
  for (int r = 0; r < 16; ++r) rli[r] = __builtin_amdgcn_rcpf(li_l[crow(r, hi)]);
  __syncthreads();
  float* xch = (float*)lds + wq * 4096 + lane;
  if (m == 1) {
#pragma unroll
    for (int d0 = 0; d0 < 4; ++d0)
#pragma unroll
      for (int r = 0; r < 16; ++r) xch[(d0 * 16 + r) * 64] = o[d0][r] * rli[r] * lam;
  }
  __syncthreads();
  if (m == 0) {
    bf16* Ow = MIX + (rowbase + qw0) * DMODEL + h * 128 + r32;
    float gsub[4];
#pragma unroll
    for (int d0 = 0; d0 < 4; ++d0) gsub[d0] = subg[d0 * 32 + r32] * post;
#pragma unroll
    for (int r = 0; r < 16; ++r) { float y[4]; float ss = 0.f;
#pragma unroll
      for (int d0 = 0; d0 < 4; ++d0) { y[d0] = o[d0][r] * rli[r] - xch[(d0 * 16 + r) * 64]; ss += y[d0] * y[d0]; }
      ss += __shfl_xor(ss, 1); ss += __shfl_xor(ss, 2); ss += __shfl_xor(ss, 4); ss += __shfl_xor(ss, 8); ss += __shfl_xor(ss, 16);
      const float rs = 1.0f / sqrtf(ss * (1.0f / 128.0f) + 1e-6f);
#pragma unroll
      for (int d0 = 0; d0 < 4; ++d0) Ow[(long)crow(r, hi) * DMODEL + d0 * 32] = __float2bfloat16(y[d0] * rs * gsub[d0]); }
  }
  if (m == 1) conv_item(P, MIX, cw, conv_base + wq, lane);
  __syncthreads();
#undef DMA_TILE
#undef WAIT_BAR
#undef RESC
#undef SCORE
}
#undef KSWZ
#undef SBAR
}
#ifndef DUP
#define DUP 0
#endif
#ifndef NO_CONV
#define NO_CONV 0
#endif
#ifndef NO_ATTU
#define NO_ATTU 0
#endif
#ifndef NO_P0
#define NO_P0 0
#endif
#ifndef NO_PROJ
#define NO_PROJ 0
#endif
#ifndef NO_ATT
#define NO_ATT 0
#endif
#ifndef NO_OUT
#define NO_OUT 0
#endif
#ifndef NO_UP
#define NO_UP 0
#endif
#ifndef NO_DN
#define NO_DN 0
#endif
#ifndef MK_PER_PHASE
#define MK_PER_PHASE 0
#endif
constexpr int NWAVES = 8;
constexpr int BATCH = 4, SEQ = 2048, T = BATCH * SEQ, D = 2048, PW = 6144, FF = 8192, NH = 8, DEPTH = 4, CONVW = 1024;
constexpr int N_PHASES = 1 + 5 * DEPTH;
constexpr size_t MiB = 1u << 20;
constexpr size_t WS_SSQ = 674 * MiB;
constexpr size_t WS_CTL = 0, CTL_ZERO_BYTES = 64 * 1024;
constexpr size_t WS_BT = 512 * 1024;
constexpr size_t WS_WIN = 2 * MiB, WS_WOUT = 98 * MiB, WS_WUP = 130 * MiB, WS_WDN = 258 * MiB;
constexpr size_t WS_XB = 386 * MiB, WS_PROJ = 418 * MiB, WS_MIX = 514 * MiB, WS_U = 546 * MiB, WS_KH = 684 * MiB, WS_VH = 700 * MiB, WS_END = 716 * MiB;
constexpr int LDS_BYTES = 147456, LDS_BARST = LDS_BYTES - 64;
#define LAS __attribute__((address_space(3)))
#define XB_TMO      128
#define XB_XCNT(j)  (256  + 64 * (j))
#define XB_XSUB(j)  (1280 + 64 * (j))
#define XB_XGEN(j)  (2304 + 64 * (j))
#define XB_TOP      3328
#define XB_TOPGEN   3392
#define XCD_BAR_WORDS 3456
#define XB_SPIN_CAP (1u << 18)

__device__ __forceinline__ unsigned xb_ld(unsigned* p)              { return __hip_atomic_load(p, __ATOMIC_RELAXED, __HIP_MEMORY_SCOPE_AGENT); }
__device__ __forceinline__ unsigned xb_add(unsigned* p, unsigned v) { return __hip_atomic_fetch_add(p, v, __ATOMIC_RELAXED, __HIP_MEMORY_SCOPE_AGENT); }
__device__ __forceinline__ unsigned xb_xcc_id() { return (unsigned)__builtin_amdgcn_s_getreg((3 << 11) | 20) & 0xFu; }
#define XB_SPIN(cond, bar) do { unsigned _sp = 0; while (cond) { __builtin_amdgcn_s_sleep(1); \
    if ((++_sp & 255u) == 0u) { if (xb_ld(&(bar)[XB_TMO])) break; if (_sp > XB_SPIN_CAP) { atomicAdd(&(bar)[XB_TMO], 1u); break; } } } } while (0)

struct XcdBarrier {
    unsigned* bar; unsigned x;
    volatile LAS unsigned* st;
};

__device__ __forceinline__ XcdBarrier xcd_barrier_post(unsigned* bar, volatile LAS unsigned* st) {
    XcdBarrier b; b.bar = bar; b.x = xb_xcc_id(); b.st = st;
    if (threadIdx.x == 0) (void)xb_add(&bar[XB_XCNT(b.x)], 1u);
    return b;
}
__device__ __forceinline__ void xcd_barrier_complete(unsigned* bar, unsigned x, unsigned& nloc, unsigned& nx) {
    const unsigned G = gridDim.x * gridDim.y * gridDim.z;
    unsigned sum, cnt, mine, sp = 0u;
    for (;;) {
        sum = 0u; cnt = 0u; mine = 0u;
#pragma unroll
        for (unsigned j = 0; j < 16; ++j) { const unsigned c = xb_ld(&bar[XB_XCNT(j)]); sum += c; cnt += (c > 0u) ? 1u : 0u; mine = (j == x) ? c : mine; }
        if (sum == G) break;
        __builtin_amdgcn_s_sleep(1);
        if ((++sp & 255u) == 0u) { if (xb_ld(&bar[XB_TMO])) break; if (sp > XB_SPIN_CAP) { atomicAdd(&bar[XB_TMO], 1u); break; } }
    }
    nloc = mine > 0u ? mine : 1u; nx = cnt > 0u ? cnt : 1u;
}

__device__ __forceinline__ void xcd_barrier(const XcdBarrier& b) {
    asm volatile("s_waitcnt vmcnt(0)" ::: "memory");
    __syncthreads();
    if (threadIdx.x == 0) {
        unsigned* bar = b.bar;
        __builtin_amdgcn_s_waitcnt(0);
        unsigned nloc = b.st[0], nx = b.st[1];
        if (nloc == 0u) { xcd_barrier_complete(bar, b.x, nloc, nx); b.st[0] = nloc; b.st[1] = nx; }
        const unsigned old = xb_add(&bar[XB_XSUB(b.x)], 1u);
        const unsigned gen = old / nloc;
        if (old + 1u == (gen + 1u) * nloc) {
            __builtin_amdgcn_fence(__ATOMIC_RELEASE, "agent");
            asm volatile("s_waitcnt vmcnt(0)" ::: "memory");
            const unsigned og = xb_add(&bar[XB_TOP], 1u);
            const unsigned tg = og / nx;
            if (og + 1u == (tg + 1u) * nx) xb_add(&bar[XB_TOPGEN], 1u);
            else XB_SPIN(xb_ld(&bar[XB_TOPGEN]) == tg, bar);
            __builtin_amdgcn_fence(__ATOMIC_ACQUIRE, "agent");
            xb_add(&bar[XB_XGEN(b.x)], 1u);
            asm volatile("s_waitcnt vmcnt(0)" ::: "memory");
        } else {
            XB_SPIN(xb_ld(&bar[XB_XGEN(b.x)]) == gen, bar);
            __builtin_amdgcn_fence(__ATOMIC_ACQUIRE, "agent");
            asm volatile("s_waitcnt vmcnt(0)" ::: "memory");
        }
    }
    __syncthreads();
}

typedef unsigned short bf16;
typedef unsigned v4u __attribute__((ext_vector_type(4)));
typedef float f32x4 __attribute__((ext_vector_type(4)));
__device__ __forceinline__ unsigned f2bf(float f) { unsigned u = __builtin_bit_cast(unsigned, f); return (u + 0x7fffu + ((u >> 16) & 1u)) >> 16; }
__device__ __forceinline__ unsigned pk2(float lo, float hi) { return f2bf(lo) | (f2bf(hi) << 16); }
__device__ __forceinline__ float wave_sum(float v) {
#pragma unroll
    for (int o = 1; o < 64; o <<= 1) v += __shfl_xor(v, o);
    return v;
}
__device__ __forceinline__ int win_row(int n) {
    if (n >= 4096) { const int isci = n >= 5120 ? 1 : 0, ch = n - (isci ? 5120 : 4096); return (16 + (ch >> 7)) * 256 + isci * 128 + (ch & 127); }
    const int c = n & 255; return (n & ~255) + ((c >> 5) & 1) * 128 + (c >> 6) * 32 + (c & 31); }
struct TItem { const float* src; const float* g; bf16* dst; int N, K, perm; };
__device__ __forceinline__ void titem_load(const TItem& d, f32x4 (&v)[16], float (&gg)[16], int lane) {
#pragma unroll
    for (int i = 0; i < 16; ++i) { const int kk = 32 * (i >> 3) + 8 * (lane >> 4) + (i & 7); v[i] = *(const f32x4*)(d.src + (size_t)kk * d.N + (lane & 15) * 4); gg[i] = d.g ? d.g[kk] : 1.f; }
}
__device__ __forceinline__ void titem_process(const TItem& d, const f32x4 (&v)[16], const float (&gg)[16], int lane) {
    const int n0 = d.perm >> 1;
#pragma unroll
    for (int j = 0; j < 4; ++j) { const int n = n0 + 4 * (lane & 15) + j, nr = (d.perm & 1) ? win_row(n) : n;
        bf16* rowp = d.dst + ((size_t)(nr >> 8) * (d.K >> 6) * 256 + (nr & 255)) * 64 + 8 * (lane >> 4);
#pragma unroll
        for (int h = 0; h < 2; ++h) { v4u o;
            o.x = pg8::cvt_pk_bf16(v[8 * h + 0][j] * gg[8 * h + 0], v[8 * h + 1][j] * gg[8 * h + 1]); o.y = pg8::cvt_pk_bf16(v[8 * h + 2][j] * gg[8 * h + 2], v[8 * h + 3][j] * gg[8 * h + 3]);
            o.z = pg8::cvt_pk_bf16(v[8 * h + 4][j] * gg[8 * h + 4], v[8 * h + 5][j] * gg[8 * h + 5]); o.w = pg8::cvt_pk_bf16(v[8 * h + 6][j] * gg[8 * h + 6], v[8 * h + 7][j] * gg[8 * h + 7]);
            *(v4u*)(rowp + 32 * h) = o; } }
}
__device__ __forceinline__ int t5_bucket(int d) {
    if (d < 16) return d;
    const int th[15] = {19, 21, 24, 27, 31, 35, 40, 46, 52, 59, 67, 77, 87, 99, 113};
    int b = 16;
#pragma unroll
    for (int i = 0; i < 15; ++i) b += (d >= th[i]) ? 1 : 0;
    return b;
}
struct Args { const float* in[18]; int ph_lo, ph_hi; };

__global__ void __launch_bounds__(NWAVES * 64, 2) hybrid_fwd(Args args) {
    extern __shared__ __attribute__((aligned(16))) unsigned char lds[];
    cg::grid_group grid = cg::this_grid();
    const int tid = threadIdx.x, lane = tid & 63, wave = __builtin_amdgcn_readfirstlane(tid >> 6);
    const int G = gridDim.x, bx = blockIdx.x;
    const int vcu = (G % 8 == 0) ? (bx % 8) * (G / 8) + bx / 8 : bx;
    const int lo = args.ph_lo, hi = args.ph_hi;
    if (tid < 16) ((volatile LAS unsigned*)((LAS unsigned char*)lds + LDS_BARST))[tid] = 0u;
    __syncthreads();
    const XcdBarrier xbar = xcd_barrier_post((unsigned*)args.in[17], (volatile LAS unsigned*)((LAS unsigned char*)lds + LDS_BARST));
#define IN(k) (lo <= (k) && (k) < hi)
#ifdef NO_SYNC
#define SEAM(k) do { } while (0)
#else
#define SEAM(k) do { if ((k) + 1 < hi) { if ((k) == 0) grid.sync(); else xcd_barrier(xbar); if (DUP & 16) { xcd_barrier(xbar); xcd_barrier(xbar); } } } while (0)
#endif

    for (int rep = 0; rep < ((DUP & 1) ? 2 : 1); ++rep)
    if (IN(0) && !NO_P0) {
        int z = 0; asm volatile("" : "+s"(z));
        unsigned char* ws = (unsigned char*)args.in[z + 17]; float* ssq = (float*)(ws + WS_SSQ); float* BT = (float*)(ws + WS_BT); bf16* XB = (bf16*)(ws + WS_XB);
        const int gw = vcu * NWAVES + wave, NGW = G * NWAVES;
        constexpr int I_IN = (D / 64) * (PW / 64), I_OUT = (D / 64) * (D / 64), I_UP = (D / 64) * (FF / 64), I_DN = (FF / 64) * (D / 64), I_L = I_IN + I_OUT + I_UP + I_DN;
        const float* const w_in = args.in[z + 1]; const float* const w_out = args.in[z + 2]; const float* const w_up = args.in[z + 13]; const float* const w_dn = args.in[z + 14];
        const float* const g_attn = args.in[z + 11]; const float* const g_mlp = args.in[z + 12];
        auto decode = [&](int it) -> TItem {
            const int l = it / I_L; int r = it % I_L; TItem d;
            const float* W; bf16* WT; const float* g = nullptr; int K = D, N = D, perm = 0;
            if (r < I_IN) { W = w_in + (size_t)l * D * PW; WT = (bf16*)(ws + WS_WIN) + (size_t)l * PW * D; N = PW; g = g_attn + l * D; perm = 1; }
            else if ((r -= I_IN) < I_OUT) { W = w_out + (size_t)l * D * D; WT = (bf16*)(ws + WS_WOUT) + (size_t)l * D * D; }
            else if ((r -= I_OUT) < I_UP) { W = w_up + (size_t)l * D * FF; WT = (bf16*)(ws + WS_WUP) + (size_t)l * FF * D; N = FF; g = g_mlp + l * D; }
            else { r -= I_UP; W = w_dn + (size_t)l * FF * D; WT = (bf16*)(ws + WS_WDN) + (size_t)l * D * FF; K = FF; }
            const int nblk = N / 64, k0 = 64 * (r / nblk), n0 = 64 * (r % nblk);
            d.src = W + (size_t)k0 * N + n0; d.g = g ? g + k0 : nullptr; d.dst = WT + (size_t)(k0 >> 6) * (256 * 64); d.N = N; d.K = K; d.perm = perm | (n0 << 1);
            return d; };
        {
            int it = gw; f32x4 va[16]; float ga[16]; TItem d0;
            if (it < DEPTH * I_L) { d0 = decode(it); titem_load(d0, va, ga, lane); }
            while (it < DEPTH * I_L) {
                const int itn = it + NGW; f32x4 vb[16]; float gb[16]; TItem d1;
                if (itn < DEPTH * I_L) { d1 = decode(itn); titem_load(d1, vb, gb, lane); }
                titem_process(d0, va, ga, lane);
                if (itn < DEPTH * I_L) {
#pragma unroll
                    for (int i = 0; i < 16; ++i) { va[i] = vb[i]; ga[i] = gb[i]; }
                    d0 = d1; }
                it = itn;
            }
        }
        const int gt = bx * (NWAVES * 64) + tid, NGT = G * NWAVES * 64;
        for (int i = gt; i < 16 * 384; i += NGT) { const int hm = i / 384, d = i % 384 - 128;
            BT[i] = d < 0 ? -1e30f : args.in[z + 15][t5_bucket(d > 127 ? 127 : d) * 16 + hm] * 1.4426950408889634f; }
        const float* x = args.in[z + 0];
        for (int row = gw; row < T; row += NGW) {
            const f32x4* xr = (const f32x4*)(x + (size_t)row * D) + lane; float s = 0.f;
            bf16* const xbrow = XB + (size_t)(row >> 8) * (D / 64) * (256 * 64) + (size_t)(row & 255) * 64;
#pragma unroll
            for (int j = 0; j < 8; ++j) { const f32x4 v = xr[64 * j]; s += (v[0] * v[0] + v[1] * v[1]) + (v[2] * v[2] + v[3] * v[3]);
                { const int col = 256 * j + 4 * lane; *(unsigned long long*)(xbrow + (size_t)(col >> 6) * (256 * 64) + (col & 63)) = (unsigned long long)pk2(v[0], v[1]) | ((unsigned long long)pk2(v[2], v[3]) << 32); } }
            s = wave_sum(s); if (lane < 32) ssq[(size_t)row * 32 + lane] = (lane == 0) ? s : 0.f;
        }
        SEAM(0);
    }

    for (int l = 0; l < DEPTH; ++l) {
        const int p0 = 1 + 5 * l;
        for (int rep = 0; rep < ((DUP & 2) ? 2 : 1); ++rep)
        if (IN(p0) && !NO_PROJ) {
            int ll = l, z = 0; asm volatile("" : "+s"(ll), "+s"(z));
            unsigned char* w = (unsigned char*)args.in[z + 17]; float* xout = (float*)args.in[z + 16];
            pg8::Gemm g{(const bf16*)(w + WS_XB), (const bf16*)(w + WS_WIN) + (size_t)ll * PW * D, T, PW, D, 1  }; pg8::StaticOrder S; S.init(T, PW, G, bx);
            pg8::EpiProj E{(bf16*)(w + WS_PROJ), (const float*)(w + WS_SSQ) + (size_t)(2 * ll) * T * 32, args.in[z + 4] + ll * 64, args.in[z + 5] + ll * 64, PW, (bf16*)(w + WS_KH), (bf16*)(w + WS_VH)};
            pg8::gemm_phase<pg8::EpiProj, pg8::StaticOrder, true, true>((LAS unsigned char*)lds, g, S, E);
            SEAM(p0);
        }
        for (int rep = 0; rep < ((DUP & 4) ? 2 : 1); ++rep)
        if (IN(p0 + 1) && !NO_ATT) {
            int ll = l, z = 0; asm volatile("" : "+s"(ll), "+s"(z));
            unsigned char* w = (unsigned char*)args.in[z + 17]; float* xout = (float*)args.in[z + 16];
            const bf16* PROJ = (const bf16*)(w + WS_PROJ); bf16* MIX = (bf16*)(w + WS_MIX); const float* BT = (const float*)(w + WS_BT);
            const float lam_init = 0.8f - 0.6f * expf(-0.3f * (float)ll);
            float a = args.in[z + 6][ll * 64 + lane] * args.in[z + 7][ll * 64 + lane], b2 = args.in[z + 8][ll * 64 + lane] * args.in[z + 9][ll * 64 + lane];
            a = wave_sum(a); b2 = wave_sum(b2);
            const float lam = expf(a) - expf(b2) + lam_init;
            float gqm = fabsf(args.in[z + 4][ll * 64 + lane]), gkm = fabsf(args.in[z + 5][ll * 64 + lane]);
#pragma unroll
            for (int o = 1; o < 64; o <<= 1) { gqm = fmaxf(gqm, __shfl_xor(gqm, o)); gkm = fmaxf(gkm, __shfl_xor(gkm, o)); }
            const float gqk = gqm * gkm;
            for (int pr = vcu; pr < BATCH * NH * 8 && !NO_ATTU; pr += G) {
                const int bh = pr >> 3, s = pr & 7;
#pragma unroll 1
                for (int half = 0; half < 2; ++half)
                {   const int qb = half == 0 ? 15 - s : s, hh = bh % NH;
                    float bm = fmaxf(fmaxf(BT[hh * 768 + 128 + lane], BT[hh * 768 + 128 + 64 + lane]), fmaxf(BT[hh * 768 + 384 + 128 + lane], BT[hh * 768 + 384 + 128 + 64 + lane]));
#pragma unroll
                    for (int o = 1; o < 64; o <<= 1) bm = fmaxf(bm, __shfl_xor(bm, o));
                    const float sref = 11.8f * gqk + bm + 0.25f;
                    if (sref <= 40.f) att::attn_unit<true>(bh / NH, hh, qb, (const att::bf16*)PROJ, (const att::bf16*)(w + WS_KH), (const att::bf16*)(w + WS_VH), (att::bf16*)MIX, BT, args.in[z + 10] + ll * 128, lam, 1.0f - lam_init, sref, args.in[z + 3] + (size_t)ll * 3 * CONVW, pr * 8 + half * 4, (char*)lds);
                    else att::attn_unit<false>(bh / NH, hh, qb, (const att::bf16*)PROJ, (const att::bf16*)(w + WS_KH), (const att::bf16*)(w + WS_VH), (att::bf16*)MIX, BT, args.in[z + 10] + ll * 128, lam, 1.0f - lam_init, 0.f, args.in[z + 3] + (size_t)ll * 3 * CONVW, pr * 8 + half * 4, (char*)lds);
                }
            }
            SEAM(p0 + 1);
        }
        if (IN(p0 + 2) && !NO_OUT) {
            int ll = l, z = 0; asm volatile("" : "+s"(ll), "+s"(z));
            unsigned char* w = (unsigned char*)args.in[z + 17]; float* xout = (float*)args.in[z + 16];
            pg8::Gemm g{(const bf16*)(w + WS_MIX), (const bf16*)(w + WS_WOUT) + (size_t)ll * D * D, T, D, D, 0}; pg8::StaticOrder S; S.init(T, D, G, bx);
            pg8::EpiResid E{(ll == 0) ? args.in[z + 0] : (const float*)nullptr, (float*)nullptr, (bf16*)(w + WS_XB), (float*)(w + WS_SSQ) + (size_t)(2 * ll + 1) * T * 32, D};
            pg8::gemm_phase<pg8::EpiResid, pg8::StaticOrder, false, true>((LAS unsigned char*)lds, g, S, E);
            SEAM(p0 + 2);
        }
        for (int rep = 0; rep < ((DUP & 8) ? 2 : 1); ++rep)
        if (IN(p0 + 3) && !NO_UP) {
            int ll = l, z = 0; asm volatile("" : "+s"(ll), "+s"(z));
            unsigned char* w = (unsigned char*)args.in[z + 17]; float* xout = (float*)args.in[z + 16];
            pg8::Gemm g{(const bf16*)(w + WS_XB), (const bf16*)(w + WS_WUP) + (size_t)ll * FF * D, T, FF, D, 1  }; pg8::StaticOrder S; S.init(T, FF, G, bx);
            pg8::EpiUp E{(bf16*)(w + WS_U), (const float*)(w + WS_SSQ) + (size_t)(2 * ll + 1) * T * 32, FF};
            pg8::gemm_phase<pg8::EpiUp, pg8::StaticOrder, true, true>((LAS unsigned char*)lds, g, S, E);
            SEAM(p0 + 3);
        }
        if (IN(p0 + 4) && !NO_DN) {
            int ll = l, z = 0; asm volatile("" : "+s"(ll), "+s"(z));
            unsigned char* w = (unsigned char*)args.in[z + 17]; float* xout = (float*)args.in[z + 16];
            pg8::Gemm g{(const bf16*)(w + WS_U), (const bf16*)(w + WS_WDN) + (size_t)ll * D * FF, T, D, FF, 1  }; pg8::StaticOrder S; S.init(T, D, G, bx);
            pg8::EpiResid E{(const float*)nullptr, (ll == DEPTH - 1) ? xout : (float*)nullptr, (bf16*)(w + WS_XB), (float*)(w + WS_SSQ) + (size_t)(2 * ll + 2) * T * 32, D};
            pg8::gemm_phase<pg8::EpiResid, pg8::StaticOrder, false, true>((LAS unsigned char*)lds, g, S, E);
            SEAM(p0 + 4);
        }
    }
#undef IN
#undef SEAM
}

extern "C" void kernel_launch(void* const* d_in, const int* in_sizes, int n_in, void* d_out, int out_size, void* d_ws, size_t ws_size, hipStream_t stream) {
    static int grid = 0;
    if (grid == 0) {
        if (n_in != 16 || in_sizes[0] != T * D || out_size != T * D || ws_size < WS_END) { fprintf(stderr, "kernel_launch: unexpected shapes (n_in %d in0 %d out %d ws %zu); nothing launched\n", n_in, n_in > 0 ? in_sizes[0] : -1, out_size, ws_size); grid = -1; return; }
        int dev = 0, cus = 0, per_cu = 0;
        if (hipGetDevice(&dev) != hipSuccess || hipDeviceGetAttribute(&cus, hipDeviceAttributeMultiprocessorCount, dev) != hipSuccess) { fprintf(stderr, "kernel_launch: device query failed\n"); grid = -1; return; }
        if (hipFuncSetAttribute((const void*)hybrid_fwd, hipFuncAttributeMaxDynamicSharedMemorySize, LDS_BYTES) != hipSuccess) { fprintf(stderr, "kernel_launch: hipFuncSetAttribute failed\n"); grid = -1; return; }
        if (hipOccupancyMaxActiveBlocksPerMultiprocessor(&per_cu, (const void*)hybrid_fwd, NWAVES * 64, LDS_BYTES) != hipSuccess || per_cu < 1) { fprintf(stderr, "kernel_launch: occupancy query says %d blocks per CU\n", per_cu); per_cu = 1; }
        (void)hipGetLastError();
        grid = cus * per_cu;
        fprintf(stderr, "kernel_launch: grid %d (%d CUs x %d)\n", grid, cus, per_cu);
    }
    if (grid < 0) return;
    if (hipMemsetAsync((char*)d_ws + WS_CTL, 0, CTL_ZERO_BYTES, stream) != hipSuccess) { fprintf(stderr, "kernel_launch: hipMemsetAsync failed\n"); return; }
    Args a{};
    for (int i = 0; i < 16; ++i) a.in[i] = (const float*)d_in[i];
    a.in[16] = (const float*)d_out; a.in[17] = (const float*)d_ws;
#if MK_PER_PHASE
    for (int ph = 0; ph < N_PHASES; ++ph) { a.ph_lo = ph; a.ph_hi = ph + 1; hipLaunchKernelGGL(hybrid_fwd, dim3(grid), dim3(NWAVES * 64), LDS_BYTES, stream, a); }
#else
    a.ph_lo = 0; a.ph_hi = N_PHASES;
    void* kargs[] = {&a};
    const hipError_t e = hipLaunchCooperativeKernel((const void*)hybrid_fwd, dim3(grid), dim3(NWAVES * 64), kargs, LDS_BYTES, stream);
    if (e != hipSuccess) fprintf(stderr, "kernel_launch: cooperative launch failed: %s (grid %d)\n", hipGetErrorString(e), grid);
#endif
    const hipError_t le = hipPeekAtLastError();
    if (le != hipSuccess) fprintf(stderr, "kernel_launch: launch error %s\n", hipGetErrorName(le));
}
```

```cpp
#include <hip/hip_runtime.h>
#include <hip/hip_bf16.h>
#include <hip/hip_cooperative_groups.h>
#include <cstdio>
#include <cstdint>
#include <cmath>
namespace cg = cooperative_groups;
namespace pg8 {
#define PG8_LAS __attribute__((address_space(3)))
typedef unsigned short bf16_t;
typedef short bf16x8 __attribute__((ext_vector_type(8)));
typedef float f32x4 __attribute__((ext_vector_type(4)));
typedef unsigned u32x4 __attribute__((ext_vector_type(4)));
constexpr int BM = 256, BK = 64, HALF = 128, HTB = HALF * BK * 2  , STAGE_BYTES = 8 * HTB, NXCD = 8, WGM = 8;

__host__ __device__ __forceinline__ int lds_byte(int r, int c) { const int st = (r >> 4) * 2 + (c >> 5), rr = r & 15, cc = c & 31, ob = rr * 64 + cc * 2; return st * 1024 + (ob ^ (((ob >> 9) & 1) << 5)); }
__host__ __device__ __forceinline__ void stage_rc(int b, int& R, int& C) { const int st = b / 1024, sb = b % 1024, swz = sb ^ (((sb >> 9) & 1) << 5); R = (st >> 1) * 16 + swz / 64; C = (st & 1) * 32 + (swz % 64) / 2; }
__host__ __device__ __forceinline__ int perm32(int rho) { const int n = rho >> 4, i = rho & 15; return 8 * (i >> 2) + 4 * n + (i & 3); }

__host__ __device__ __forceinline__ int blk_off(int r, int c) { const int rr = r & 127; return (r >> 7) * 8192 + (((rr >> 4) * 2 + (c >> 5)) * 512) + (rr & 15) * 32 + (c & 31); }
struct Unit { int pm, pn; };
struct Gemm { const bf16_t* A; const bf16_t* Bt; int M, N, K; int a_blocked; };

struct StaticOrder {
    int nM, nN, nwg, G, c;
    __host__ __device__ void init(int M, int N, int G_, int c_) { nM = M / BM; nN = N / BM; nwg = nM * nN; G = G_; c = c_; }
    __host__ __device__ bool next(int i, Unit& u) const {
        const long L = (long)i * G + c; if (L >= nwg) return false;
        int wgid = (int)L; { const int q = nwg / NXCD, r = nwg % NXCD, xcd = wgid % NXCD, off = wgid / NXCD; wgid = (xcd < r ? xcd * (q + 1) : r * (q + 1) + (xcd - r) * q) + off; }
        const int nig = WGM * nN, gid = wgid / nig, fm = gid * WGM, gsz = (nM - fm) < WGM ? (nM - fm) : WGM;
        u.pm = fm + ((wgid % nig) % gsz); u.pn = (wgid % nig) / gsz; return true;
    }
    __device__ __forceinline__ void a_ready(const Unit&) const {}
    __device__ __forceinline__ void done(const Unit&) const {}
};

__device__ __forceinline__ unsigned cvt_pk_bf16(float lo, float hi) { unsigned r; asm volatile("v_cvt_pk_bf16_f32 %0, %1, %2" : "=v"(r) : "v"(lo), "v"(hi)); return r; }
typedef float f32x2 __attribute__((ext_vector_type(2)));
constexpr float RMS_EPS = 1e-6f;
constexpr float QC2 = 0.125f * 1.4426950408889634f;
typedef unsigned u32x2e __attribute__((ext_vector_type(2)));
__device__ __forceinline__ float row_rstd(const float* ssq, int row) {
    const f32x4* p = (const f32x4*)(ssq + (size_t)row * 32); f32x4 a = p[0];
#pragma unroll
    for (int i = 1; i < 8; ++i) a = a + p[i];
    return 1.0f / sqrtf(((a[0] + a[1]) + (a[2] + a[3])) * (1.0f / 2048.0f) + RMS_EPS);
}
__device__ __forceinline__ void zero_acc(f32x4 (&acc)[2][2][4][2]) {
#pragma unroll
    for (int a = 0; a < 2; ++a)
#pragma unroll
        for (int b = 0; b < 2; ++b)
#pragma unroll
            for (int m = 0; m < 4; ++m)
#pragma unroll
                for (int n = 0; n < 2; ++n) acc[a][b][m][n] = (f32x4){0.f, 0.f, 0.f, 0.f};
}
__device__ __forceinline__ void rows_rstd(float (&rs)[2][4], const float* ssq, int row0, int fq) {
    f32x4 pa[2][4], pb[2][4];
#pragma unroll
    for (int ai = 0; ai < 2; ++ai)
#pragma unroll
        for (int m = 0; m < 4; ++m) { const f32x4* p = (const f32x4*)(ssq + (size_t)(row0 + ai * HALF + m * 16) * 32 + 8 * fq); pa[ai][m] = p[0]; pb[ai][m] = p[1]; }
#pragma unroll
    for (int ai = 0; ai < 2; ++ai)
#pragma unroll
        for (int m = 0; m < 4; ++m) { const f32x4 a = pa[ai][m] + pb[ai][m]; float t = (a[0] + a[1]) + (a[2] + a[3]);
            t += __shfl_xor(t, 16); t += __shfl_xor(t, 32); rs[ai][m] = 1.0f / sqrtf(t * (1.0f / 2048.0f) + RMS_EPS); }
}
struct RsState { f32x4 ra, rb; int pm; };
struct NoState { int pm; };
struct EpiProj {
    typedef RsState State; static constexpr int KR = 1;
    static constexpr bool PERM = true, AFTER_DRAIN = false;
    bf16_t* O; const float* ssq; const float* qg; const float* kg; int ldc;
    __device__ __forceinline__ void init(f32x4 (&acc)[2][2][4][2], State& st, const Unit& u, int wr, int, int fr, int fq) const { zero_acc(acc);
        if (st.pm != u.pm) { float t[2][4]; rows_rstd(t, ssq, u.pm * BM + wr * 64 + fr, fq); st.ra = (f32x4){t[0][0], t[0][1], t[0][2], t[0][3]}; st.rb = (f32x4){t[1][0], t[1][1], t[1][2], t[1][3]}; st.pm = u.pm; } }
    __device__ __forceinline__ void operator()(const f32x4 (&acc)[2][2][4][2], const State& st, const Unit& u, int wr, int wc, int fr, int fq) const {
        const int row0 = u.pm * BM + wr * 64 + fr, col0 = u.pn * BM + wc * 64 + 8 * fq;
        const float rsv[2][4] = {{st.ra[0], st.ra[1], st.ra[2], st.ra[3]}, {st.rb[0], st.rb[1], st.rb[2], st.rb[3]}};
        const bool qk = u.pn < 8, isq = u.pn < 4;
        f32x4 g[2][2];
#pragma unroll
        for (int bj = 0; bj < 2; ++bj)
#pragma unroll
            for (int n = 0; n < 2; ++n) { g[bj][n] = (f32x4){1.f, 1.f, 1.f, 1.f};
                if (qk) { g[bj][n] = *(const f32x4*)((isq ? qg : kg) + 32 * bj + 8 * fq + 4 * n); if (isq) g[bj][n] = g[bj][n] * QC2; } }
#pragma unroll
        for (int ai = 0; ai < 2; ++ai)
#pragma unroll
            for (int m = 0; m < 4; ++m) { const int row = row0 + ai * HALF + m * 16;
                const float rs = rsv[ai][m];
                f32x4 v[2][2];
#pragma unroll
                for (int bj = 0; bj < 2; ++bj)
#pragma unroll
                    for (int n = 0; n < 2; ++n) v[bj][n] = acc[ai][bj][m][n] * rs;
                if (qk) { float s = 0.f;
#pragma unroll
                    for (int bj = 0; bj < 2; ++bj)
#pragma unroll
                        for (int n = 0; n < 2; ++n) { const f32x4 x = v[bj][n]; s += (x[0] * x[0] + x[1] * x[1]) + (x[2] * x[2] + x[3] * x[3]); }
                    s += __shfl_xor(s, 16); s += __shfl_xor(s, 32);
                    const float r = 1.0f / sqrtf(s * (1.0f / 64.0f) + RMS_EPS);
#pragma unroll
                    for (int bj = 0; bj < 2; ++bj)
#pragma unroll
                        for (int n = 0; n < 2; ++n) v[bj][n] = v[bj][n] * r * g[bj][n]; }
                if (u.pn >= 16) {
                    const f32x4 q0 = v[0][0] * v[1][0], q1 = v[0][1] * v[1][1];
                    u32x4 w; w.x = cvt_pk_bf16(q0[0], q0[1]); w.y = cvt_pk_bf16(q0[2], q0[3]); w.z = cvt_pk_bf16(q1[0], q1[1]); w.w = cvt_pk_bf16(q1[2], q1[3]);
                    *(u32x4*)(O + (size_t)row * ldc + 4096 + (u.pn - 16) * 128 + wc * 32 + 8 * fq) = w;
                } else {
                bf16_t* rowp = O + (size_t)row * ldc + col0;
#pragma unroll
                for (int bj = 0; bj < 2; ++bj) { u32x4 w; w.x = cvt_pk_bf16(v[bj][0][0], v[bj][0][1]); w.y = cvt_pk_bf16(v[bj][0][2], v[bj][0][3]); w.z = cvt_pk_bf16(v[bj][1][0], v[bj][1][1]); w.w = cvt_pk_bf16(v[bj][1][2], v[bj][1][3]);
                    *(u32x4*)(rowp + 32 * bj) = w; } } }
    }
};
struct EpiUp {
    typedef RsState State; static constexpr int KR = 1;
    static constexpr bool PERM = true, AFTER_DRAIN = false;
    bf16_t* O; const float* ssq; int ldc;
    __device__ __forceinline__ void init(f32x4 (&acc)[2][2][4][2], State& st, const Unit& u, int wr, int, int fr, int fq) const { zero_acc(acc);
        if (st.pm != u.pm) { float t[2][4]; rows_rstd(t, ssq, u.pm * BM + wr * 64 + fr, fq); st.ra = (f32x4){t[0][0], t[0][1], t[0][2], t[0][3]}; st.rb = (f32x4){t[1][0], t[1][1], t[1][2], t[1][3]}; st.pm = u.pm; } }
    __device__ __forceinline__ void operator()(const f32x4 (&acc)[2][2][4][2], const State& st, const Unit& u, int wr, int wc, int fr, int fq) const {
        const int row0 = u.pm * BM + wr * 64 + fr, col0 = u.pn * BM + wc * 32 + 8 * fq;
        const float rsv[2][4] = {{st.ra[0], st.ra[1], st.ra[2], st.ra[3]}, {st.rb[0], st.rb[1], st.rb[2], st.rb[3]}};
#pragma unroll
        for (int ai = 0; ai < 2; ++ai)
#pragma unroll
            for (int m = 0; m < 4; ++m) { const int row = row0 + ai * HALF + m * 16;
                const float rs = rsv[ai][m];
                bf16_t* rowp = O + (size_t)(row >> 8) * (ldc >> 6) * (256 * 64);
#pragma unroll
                for (int bj = 0; bj < 2; ++bj) { f32x4 v0 = acc[ai][bj][m][0] * rs, v1 = acc[ai][bj][m][1] * rs;
#pragma unroll
                    for (int e = 0; e < 4; ++e) { const float a = fmaxf(v0[e], 0.f), b = fmaxf(v1[e], 0.f); v0[e] = a * a; v1[e] = b * b; }
                    u32x4 w; w.x = cvt_pk_bf16(v0[0], v0[1]); w.y = cvt_pk_bf16(v0[2], v0[3]); w.z = cvt_pk_bf16(v1[0], v1[1]); w.w = cvt_pk_bf16(v1[2], v1[3]);
                    { const int col = col0 + bj * HALF; *(u32x4*)(rowp + (size_t)(col >> 6) * (256 * 64) + blk_off(row & 255, col & 63)) = w; } } }
    }
};
struct EpiResid {
    typedef NoState State; static constexpr int KR = 1;
    static constexpr bool PERM = true, AFTER_DRAIN = false;
    const float* xin_f; float* xout_f; bf16_t* xb; float* ssq; int ldc;
    __device__ __forceinline__ size_t xb_off(int row, int col) const { return ((size_t)(row >> 8) * (ldc >> 6) + (col >> 6)) * (256 * 64) + blk_off(row & 255, col & 63); }
    __device__ __forceinline__ void init(f32x4 (&acc)[2][2][4][2], State&, const Unit& u, int wr, int wc, int fr, int fq) const {
        const int row0 = u.pm * BM + wr * 64 + fr, col0 = u.pn * BM + wc * 32 + 8 * fq;
        if (xin_f) {
#pragma unroll
            for (int ai = 0; ai < 2; ++ai)
#pragma unroll
                for (int m = 0; m < 4; ++m) { const size_t off = (size_t)(row0 + ai * HALF + m * 16) * ldc + col0;
#pragma unroll
                    for (int bj = 0; bj < 2; ++bj)
#pragma unroll
                        for (int n = 0; n < 2; ++n) acc[ai][bj][m][n] = *(const f32x4*)(xin_f + off + bj * HALF + n * 4); }
        } else {
#pragma unroll
            for (int ai = 0; ai < 2; ++ai)
#pragma unroll
                for (int m = 0; m < 4; ++m) { const size_t off = (size_t)(row0 + ai * HALF + m * 16) * ldc + col0;
#pragma unroll
                    for (int bj = 0; bj < 2; ++bj) { const u32x4 w = *(const u32x4*)(xb + xb_off(row0 + ai * HALF + m * 16, col0 + bj * HALF));
                        acc[ai][bj][m][0] = (f32x4){__uint_as_float(w.x << 16), __uint_as_float(w.x & 0xffff0000u), __uint_as_float(w.y << 16), __uint_as_float(w.y & 0xffff0000u)};
                        acc[ai][bj][m][1] = (f32x4){__uint_as_float(w.z << 16), __uint_as_float(w.z & 0xffff0000u), __uint_as_float(w.w << 16), __uint_as_float(w.w & 0xffff0000u)}; } }
        }
    }
    __device__ __forceinline__ void operator()(const f32x4 (&acc)[2][2][4][2], const State&, const Unit& u, int wr, int wc, int fr, int fq) const {
        const int row0 = u.pm * BM + wr * 64 + fr, col0 = u.pn * BM + wc * 32 + 8 * fq;
        if (xout_f) {
#pragma unroll
            for (int ai = 0; ai < 2; ++ai)
#pragma unroll
                for (int m = 0; m < 4; ++m) { const size_t off = (size_t)(row0 + ai * HALF + m * 16) * ldc + col0;
#pragma unroll
                    for (int bj = 0; bj < 2; ++bj)
#pragma unroll
                        for (int n = 0; n < 2; ++n) *(f32x4*)(xout_f + off + bj * HALF + n * 4) = acc[ai][bj][m][n]; }
        } else {
#pragma unroll
            for (int ai = 0; ai < 2; ++ai)
#pragma unroll
                for (int m = 0; m < 4; ++m) { const int row = row0 + ai * HALF + m * 16; const size_t off = (size_t)row * ldc + col0; float ss = 0.f;
#pragma unroll
                    for (int bj = 0; bj < 2; ++bj) { const f32x4 v0 = acc[ai][bj][m][0], v1 = acc[ai][bj][m][1];
                        u32x4 w; w.x = cvt_pk_bf16(v0[0], v0[1]); w.y = cvt_pk_bf16(v0[2], v0[3]); w.z = cvt_pk_bf16(v1[0], v1[1]); w.w = cvt_pk_bf16(v1[2], v1[3]);
                        *(u32x4*)(xb + xb_off(row, col0 + bj * HALF)) = w;
                        ss += ((v0[0] * v0[0] + v0[1] * v0[1]) + (v0[2] * v0[2] + v0[3] * v0[3])) + ((v1[0] * v1[0] + v1[1] * v1[1]) + (v1[2] * v1[2] + v1[3] * v1[3])); }
                    ss += __shfl_xor(ss, 16); ss += __shfl_xor(ss, 32);
                    if (fq == 0) ssq[(size_t)row * 32 + u.pn * 4 + wc] = ss; }
        }
    }
};
#ifndef KREP
#define KREP 1
#endif
template <class Epi, class Sched, bool ALIGN_EPI = false, bool SP2 = false>
__device__ __forceinline__ void gemm_phase(PG8_LAS unsigned char* lds, const Gemm g, const Sched& S, const Epi& E) {
    int tid_ = threadIdx.x; asm volatile("" : "+v"(tid_));
    const int tid = tid_, wid = __builtin_amdgcn_readfirstlane(tid >> 6), lane = tid & 63, wr = wid >> 2, wc = wid & 3, fr = lane & 15, fq = lane >> 4;
    const int K = g.K, nt = K / BK;
    constexpr int KR = (KREP == 2) ? 2 : Epi::KR;
    const int Ka = g.a_blocked ? BK : g.K;
    unsigned voffA[2], voffB[2];
#pragma unroll
    for (int i = 0; i < 2; ++i) { int R, C; stage_rc(tid * 16 + i * 8192, R, C); const int Rb = Epi::PERM ? ((R & ~31) + perm32(R & 31)) : R;
        voffA[i] = g.a_blocked ? (unsigned)blk_off(R, C) * 2u : (unsigned)(R * Ka + C) * 2u; voffB[i] = (unsigned)blk_off(Rb, C) * 2u; }
    const size_t kstep = (size_t)(BK * 2);
    const size_t hstep = (size_t)HALF * K * 2;
    const size_t kstepB = (size_t)(BM * BK * 2), hstepB = (size_t)(HALF * BK * 2);
    const size_t kstepA = g.a_blocked ? (size_t)(BM * BK * 2) : kstep, hstepA = g.a_blocked ? (size_t)(HALF * BK * 2) : hstep;
    const size_t tstep = 2 * hstep;
    const unsigned ldsw = (unsigned)wid * 1024u;
    const int aoff = lds_byte(wr * 64 + fr, fq * 8), boff = lds_byte(wc * 32 + fr, fq * 8);
#define PG8_SA(b, h) (((b) * 2 + (h)) * HTB)
#define PG8_SB(b, h) ((4 + (b) * 2 + (h)) * HTB)
#define PG8_STAGE(bufoff, gbase, voff) do { _Pragma("unroll") for (int _i = 0; _i < 2; ++_i) \
        __builtin_amdgcn_global_load_lds((const unsigned*)((const char*)(gbase) + (voff)[_i]), (PG8_LAS unsigned*)(lds + (bufoff) + ldsw + _i * 8192), 16, 0, 0); } while (0)
#define PG8_LDA(dst, b, h) do { _Pragma("unroll") for (int m = 0; m < 4; ++m) _Pragma("unroll") for (int k = 0; k < 2; ++k) dst[m][k] = *(const PG8_LAS bf16x8*)(lds + PG8_SA(b, h) + aoff + m * 2048 + k * 1024); } while (0)
#define PG8_LDB(dst, b, h) do { _Pragma("unroll") for (int n = 0; n < 2; ++n) _Pragma("unroll") for (int k = 0; k < 2; ++k) dst[n][k] = *(const PG8_LAS bf16x8*)(lds + PG8_SB(b, h) + boff + n * 2048 + k * 1024); } while (0)
#define PG8_MMA(ai, bj, At, Bt) do { __builtin_amdgcn_s_setprio(1); _Pragma("unroll") for (int m = 0; m < 4; ++m) _Pragma("unroll") for (int n = 0; n < 2; ++n) _Pragma("unroll") for (int k = 0; k < 2; ++k) \
        acc[ai][bj][m][n] = __builtin_amdgcn_mfma_f32_16x16x32_bf16(Bt[n][k], At[m][k], acc[ai][bj][m][n], 0, 0, 0); __builtin_amdgcn_s_setprio(0); } while (0)
#define PG8_WAIT_V(n) asm volatile("s_waitcnt vmcnt(" #n ")" ::: "memory")
#define PG8_WAIT_L(n) asm volatile("s_waitcnt lgkmcnt(" #n ")" ::: "memory")
#define PG8_BAR __builtin_amdgcn_s_barrier()
#define PG8_SCHED __builtin_amdgcn_sched_barrier(0)
    Unit cur, nxt; int ui = 0;
    if (!S.next(0, cur)) return;
    f32x4 acc[2][2][4][2];
    typename Epi::State est; est.pm = -1;
    E.init(acc, est, cur, wr, wc, fr, fq);
    bf16x8 At[4][2], B0[2][2], B1[2][2];
    const char* cA = (const char*)g.A + (size_t)cur.pm * tstep; const char* cB = (const char*)g.Bt + (size_t)cur.pn * tstep;
    S.a_ready(cur);
    if constexpr (SP2) {
        PG8_STAGE(PG8_SB(0, 0), cB, voffB); PG8_STAGE(PG8_SB(0, 1), cB + hstepB, voffB); PG8_STAGE(PG8_SA(0, 0), cA, voffA); PG8_STAGE(PG8_SA(0, 1), cA + hstepA, voffA);
        if (wr == 1) PG8_BAR;
        PG8_WAIT_V(2); PG8_BAR;
        PG8_STAGE(PG8_SB(1, 0), cB + kstepB, voffB); PG8_STAGE(PG8_SA(1, 0), cA + kstepA, voffA); PG8_STAGE(PG8_SB(1, 1), cB + hstepB + kstepB, voffB);
        PG8_WAIT_V(6); PG8_BAR;
    } else {
        PG8_STAGE(PG8_SB(0, 0), cB, voffB); PG8_STAGE(PG8_SA(0, 0), cA, voffA); PG8_STAGE(PG8_SB(0, 1), cB + hstepB, voffB); PG8_STAGE(PG8_SA(0, 1), cA + hstepA, voffA);
        if (wr == 1) PG8_BAR;
        PG8_WAIT_V(4); PG8_BAR;
        PG8_STAGE(PG8_SB(1, 0), cB + kstepB, voffB); PG8_STAGE(PG8_SA(1, 0), cA + kstepA, voffA); PG8_STAGE(PG8_SB(1, 1), cB + hstepB + kstepB, voffB);
        PG8_WAIT_V(6); PG8_BAR;
    }
    for (;;) {
        const bool has_next = S.next(ui + 1, nxt);
        const char* nA = has_next ? (const char*)g.A + (size_t)nxt.pm * tstep : cA; const char* nB = has_next ? (const char*)g.Bt + (size_t)nxt.pn * tstep : cB;
        for (int t0_ = 0; t0_ < KR * nt; t0_ += 2) {
            const bool last = (t0_ == KR * nt - 2); const int t = (KR == 1) ? t0_ : (t0_ % nt), t2_ = (KR == 1) ? t0_ + 2 : ((t0_ + 2) % nt);
            const char* a1 = cA + (size_t)(t + 1) * kstepA;
            const char* a2 = last ? nA : cA + (size_t)t2_ * kstepA; const char* b2 = last ? nB : cB + (size_t)t2_ * kstepB;
            const char* a3 = a2 + kstepA; const char* b3 = b2 + kstepB;
            if (last && has_next) S.a_ready(nxt);
            if constexpr (SP2) {
            PG8_LDB(B0, 0, 0); PG8_LDB(B1, 0, 1); PG8_SCHED; PG8_LDA(At, 0, 0); PG8_STAGE(PG8_SA(1, 1), a1 + hstepA, voffA);
            PG8_WAIT_V(8); PG8_WAIT_L(0); PG8_BAR; PG8_MMA(0, 0, At, B0); PG8_MMA(0, 1, At, B1); PG8_BAR; PG8_SCHED;
            PG8_LDA(At, 0, 1); PG8_STAGE(PG8_SB(0, 0), b2, voffB); PG8_STAGE(PG8_SB(0, 1), b2 + hstepB, voffB); PG8_STAGE(PG8_SA(0, 0), a2, voffA);
            PG8_WAIT_V(8); PG8_WAIT_L(0); PG8_BAR; PG8_MMA(1, 0, At, B0); PG8_MMA(1, 1, At, B1); PG8_BAR; PG8_SCHED;
            PG8_LDB(B0, 1, 0); PG8_LDB(B1, 1, 1); PG8_SCHED; PG8_LDA(At, 1, 0); PG8_STAGE(PG8_SA(0, 1), a2 + hstepA, voffA);
            PG8_WAIT_V(8); PG8_WAIT_L(0); PG8_BAR; PG8_MMA(0, 0, At, B0); PG8_MMA(0, 1, At, B1); PG8_BAR; PG8_SCHED;
            PG8_LDA(At, 1, 1); PG8_STAGE(PG8_SB(1, 0), b3, voffB); PG8_STAGE(PG8_SB(1, 1), b3 + hstepB, voffB); PG8_STAGE(PG8_SA(1, 0), a3, voffA);
            PG8_WAIT_V(8); PG8_WAIT_L(0); PG8_BAR; PG8_MMA(1, 0, At, B0); PG8_MMA(1, 1, At, B1); PG8_BAR; PG8_SCHED;
            } else {
            PG8_LDB(B0, 0, 0); PG8_SCHED; PG8_LDA(At, 0, 0); PG8_STAGE(PG8_SA(1, 1), a1 + hstepA, voffA);
            PG8_WAIT_L(8); PG8_BAR; PG8_WAIT_L(0); PG8_MMA(0, 0, At, B0); PG8_BAR; PG8_SCHED;
            PG8_LDB(B1, 0, 1); PG8_STAGE(PG8_SB(0, 0), b2, voffB);
            PG8_BAR; PG8_WAIT_L(0); PG8_MMA(0, 1, At, B1); PG8_BAR;
            PG8_LDA(At, 0, 1); PG8_STAGE(PG8_SA(0, 0), a2, voffA);
            PG8_BAR; PG8_WAIT_L(0); PG8_MMA(1, 0, At, B0); PG8_BAR; PG8_SCHED;
            PG8_STAGE(PG8_SB(0, 1), b2 + hstepB, voffB);
            PG8_WAIT_V(6); PG8_BAR; PG8_MMA(1, 1, At, B1); PG8_BAR;
            PG8_LDB(B0, 1, 0); PG8_SCHED; PG8_LDA(At, 1, 0); PG8_STAGE(PG8_SA(0, 1), a2 + hstepA, voffA);
            PG8_WAIT_L(8); PG8_BAR; PG8_WAIT_L(0); PG8_MMA(0, 0, At, B0); PG8_BAR; PG8_SCHED;
            PG8_LDB(B1, 1, 1); PG8_STAGE(PG8_SB(1, 0), b3, voffB);
            PG8_BAR; PG8_WAIT_L(0); PG8_MMA(0, 1, At, B1); PG8_BAR;
            PG8_LDA(At, 1, 1); PG8_STAGE(PG8_SA(1, 0), a3, voffA);
            PG8_BAR; PG8_WAIT_L(0); PG8_MMA(1, 0, At, B0); PG8_BAR; PG8_SCHED;
            PG8_STAGE(PG8_SB(1, 1), b3 + hstepB, voffB);
            PG8_WAIT_V(6); PG8_BAR; PG8_MMA(1, 1, At, B1); PG8_BAR;
            }
        }
        if constexpr (KR == 2) {
#pragma unroll
            for (int a = 0; a < 2; ++a)
#pragma unroll
                for (int b = 0; b < 2; ++b)
#pragma unroll
                    for (int m = 0; m < 4; ++m)
#pragma unroll
                        for (int n = 0; n < 2; ++n) acc[a][b][m][n] = acc[a][b][m][n] * 0.5f;
        }
        if constexpr (ALIGN_EPI) { if (wr == 0) PG8_BAR; }
        if constexpr (!Epi::AFTER_DRAIN) { E(acc, est, cur, wr, wc, fr, fq); S.done(cur); }
        if (!has_next) break;
        E.init(acc, est, nxt, wr, wc, fr, fq);
        cur = nxt; cA = nA; cB = nB; ++ui;
        if constexpr (ALIGN_EPI) { if (wr == 1) PG8_BAR; }
    }
    PG8_WAIT_V(0);
    if constexpr (!ALIGN_EPI) { if (wr == 0) PG8_BAR; }
    PG8_BAR;
    if constexpr (Epi::AFTER_DRAIN) { E.fused(acc, cur, wr, wc, fr, fq, lds, wid, lane); S.done(cur); }
#undef PG8_SA
#undef PG8_SB
#undef PG8_STAGE
#undef PG8_LDA
#undef PG8_LDB
#undef PG8_MMA
#undef PG8_WAIT_V
#undef PG8_WAIT_L
#undef PG8_BAR
#undef PG8_SCHED
}
}
namespace att {
using bf16 = __hip_bfloat16;
using bf16x8 = __attribute__((ext_vector_type(8))) short;
using s16x4 = __attribute__((ext_vector_type(4))) short;
using f32x16 = __attribute__((ext_vector_type(16))) float;
using u32x4 = __attribute__((ext_vector_type(4))) unsigned;
constexpr int SEQ = 2048, PW = 6144, DMODEL = 2048, KVBLK = 64, QB = 128;
constexpr int SHM_V = KVBLK * 128 * 2, SHM_K = KVBLK * 128 * 2;
constexpr int NSLOT = 3, SLOTB = SHM_K + SHM_V;
constexpr int LDS_WS = NSLOT * SLOTB, LDS_BT = LDS_WS + 8 * 64 * 4, LDS_END = LDS_BT + 2 * 384 * 4;
constexpr float THR2 = 8.0f;
#define KSWZ(row, colB) ((row) * 256 + ((colB) ^ (((row) & 7) << 4)))
#define SBAR() __builtin_amdgcn_sched_barrier(0)
__device__ __forceinline__ int crow(int r, int hi) { return (r & 3) + 8 * (r >> 2) + 4 * hi; }
__device__ __forceinline__ unsigned cvtpk(float lo, float hi) { unsigned r; asm volatile("v_cvt_pk_bf16_f32 %0, %1, %2" : "=v"(r) : "v"(lo), "v"(hi)); return r; }
__device__ __forceinline__ void partialSM(f32x16& p0, f32x16& p1, float& m_reg, float& alpha, float cadd) {
  float pmax = p0[0];
#pragma unroll
  for (int r = 1; r < 16; ++r) pmax = fmaxf(pmax, p0[r]);
#pragma unroll
  for (int r = 0; r < 16; ++r) pmax = fmaxf(pmax, p1[r]);
  { auto rr = __builtin_amdgcn_permlane32_swap(__float_as_uint(pmax), __float_as_uint(pmax), false, false);
    pmax = fmaxf(__uint_as_float(rr[0]), __uint_as_float(rr[1])) + cadd; }
  if (__builtin_expect(__all(pmax - m_reg <= THR2), 1)) { alpha = 1.f; }
  else { const float mn = fmaxf(m_reg, pmax); alpha = __builtin_amdgcn_exp2f(m_reg - mn); m_reg = mn; }
  const float sh = cadd - m_reg;
#pragma unroll
  for (int r = 0; r < 16; ++r) { p0[r] += sh; p1[r] += sh; }
#pragma unroll
  for (int r = 0; r < 16; ++r) p0[r] = __builtin_amdgcn_exp2f(p0[r]);
}
__device__ __forceinline__ void finishSM(f32x16& p0, f32x16& p1, float alpha, float& l_reg, bf16x8& pa0, bf16x8& pa1, bf16x8& pa2, bf16x8& pa3) {
#pragma unroll
  for (int r = 0; r < 16; ++r) p1[r] = __builtin_amdgcn_exp2f(p1[r]);
  float ps = 0;
#pragma unroll
  for (int r = 0; r < 16; ++r) ps += p0[r];
#pragma unroll
  for (int r = 0; r < 16; ++r) ps += p1[r];
  { auto rr = __builtin_amdgcn_permlane32_swap(__float_as_uint(ps), __float_as_uint(ps), false, false);
    ps = __uint_as_float(rr[0]) + __uint_as_float(rr[1]); }
  l_reg = l_reg * alpha + ps;
#define PK4(P, BASE, OUT) do { unsigned a0 = cvtpk(P[BASE + 0], P[BASE + 1]), a1 = cvtpk(P[BASE + 2], P[BASE + 3]);   \
    unsigned b0 = cvtpk(P[BASE + 4], P[BASE + 5]), b1 = cvtpk(P[BASE + 6], P[BASE + 7]);                              \
    auto r0 = __builtin_amdgcn_permlane32_swap(a0, b0, false, false); auto r1 = __builtin_amdgcn_permlane32_swap(a1, b1, false, false); \
    u32x4 w = {r0[0], r1[0], r0[1], r1[1]}; OUT = *reinterpret_cast<bf16x8*>(&w); } while (0)
  PK4(p0, 0, pa0); PK4(p0, 8, pa1); PK4(p1, 0, pa2); PK4(p1, 8, pa3);
#undef PK4
}
__device__ __forceinline__ void qkt(f32x16& p0, f32x16& p1, const char* Ks, const bf16x8* qr, int r32, int hi, int m, const f32x16& cinit) {
  bf16x8 kf[8];
#pragma unroll
  for (int d0 = 0; d0 < 4; ++d0) { const int cb = (m * 64 + d0 * 16 + hi * 8) * 2;
    kf[2 * d0] = *reinterpret_cast<const bf16x8*>(Ks + KSWZ(r32, cb)); kf[2 * d0 + 1] = *reinterpret_cast<const bf16x8*>(Ks + KSWZ(32 + r32, cb)); }
  SBAR();
  p0 = __builtin_amdgcn_mfma_f32_32x32x16_bf16(kf[0], qr[0], cinit, 0, 0, 0);
  p1 = __builtin_amdgcn_mfma_f32_32x32x16_bf16(kf[1], qr[0], cinit, 0, 0, 0);
#pragma unroll
  for (int d0 = 1; d0 < 4; ++d0) {
    p0 = __builtin_amdgcn_mfma_f32_32x32x16_bf16(kf[2 * d0], qr[d0], p0, 0, 0, 0);
    p1 = __builtin_amdgcn_mfma_f32_32x32x16_bf16(kf[2 * d0 + 1], qr[d0], p1, 0, 0, 0); }
  SBAR();
}
__device__ __forceinline__ void bias_mask(f32x16& p0, f32x16& p1, const float* bt, int base) {
#pragma unroll
  for (int r = 0; r < 16; ++r) { const int c = (r & 3) + 8 * (r >> 2); p0[r] += bt[base - c]; }
  SBAR();
#pragma unroll
  for (int r = 0; r < 16; ++r) { const int c = (r & 3) + 8 * (r >> 2); p1[r] += bt[base - c - 32]; }
}
__device__ __forceinline__ int v_st(int k, int c) { const int kk = (k & ~0xC) | ((k & 4) << 1) | ((k & 8) >> 1); return ((kk >> 3) * 4 + (c >> 5)) * 512 + ((kk & 7) * 32 + (c & 31)) * 2; }
__device__ __forceinline__ int v_rd_base(int lane) { return ((lane & 3) << 3) | (((lane >> 2) & 3) << 6) | (((lane >> 4) & 1) << 5) | (((lane >> 5) & 1) << 8); }
constexpr int v_rd_off(int d0, int ks, int half) { return d0 * 512 + ks * 4096 + half * 2048; }
typedef short v4i16_t __attribute__((ext_vector_type(4)));
typedef __attribute__((address_space(3))) const char* lds_cptr;
__device__ __forceinline__ s16x4 vtr(lds_cptr p) { return __builtin_bit_cast(s16x4, __builtin_amdgcn_ds_read_tr16_b64_v4i16((__attribute__((address_space(3))) v4i16_t*)p)); }
struct VFrag { s16x4 lo[4], hi[4]; };
template <int KS> __device__ __forceinline__ void v_read(VFrag& f, lds_cptr vp) {
#pragma unroll
  for (int d0 = 0; d0 < 4; ++d0) { f.lo[d0] = vtr(vp + v_rd_off(d0, KS, 0)); f.hi[d0] = vtr(vp + v_rd_off(d0, KS, 1)); }
}
__device__ __forceinline__ void pv_slice(f32x16* o, const VFrag& f, bf16x8 pa) {
#pragma unroll
  for (int d0 = 0; d0 < 4; ++d0) { const bf16x8 vf = (bf16x8){f.lo[d0][0], f.lo[d0][1], f.lo[d0][2], f.lo[d0][3], f.hi[d0][0], f.hi[d0][1], f.hi[d0][2], f.hi[d0][3]};
    o[d0] = __builtin_amdgcn_mfma_f32_32x32x16_bf16(pa, vf, o[d0], 0, 0, 0); }
}
__device__ __forceinline__ void pv_all(f32x16* o, lds_cptr vp, bf16x8 pa0, bf16x8 pa1, bf16x8 pa2, bf16x8 pa3) {
  VFrag fa, fb;
  v_read<0>(fa, vp); v_read<1>(fb, vp); SBAR();
  pv_slice(o, fa, pa0); SBAR(); v_read<2>(fa, vp); SBAR();
  pv_slice(o, fb, pa1); SBAR(); v_read<3>(fb, vp); SBAR();
  pv_slice(o, fa, pa2); SBAR();
  pv_slice(o, fb, pa3); SBAR();
}
__device__ __forceinline__ void conv_item(const bf16* __restrict__ P, bf16* __restrict__ MIX, const float* __restrict__ cw, int it, int lane) {
  const unsigned short* Pu = reinterpret_cast<const unsigned short*>(P); unsigned short* Mu = reinterpret_cast<unsigned short*>(MIX);
  const int t0 = it * 4; const bool first = (t0 % SEQ) == 0;
#pragma unroll
  for (int j = 0; j < 2; ++j) { const int c0 = j * 512 + lane * 8;
    float w0[8], w1[8], w2[8];
#pragma unroll
    for (int e = 0; e < 8; ++e) { w0[e] = cw[c0 + e]; w1[e] = cw[1024 + c0 + e]; w2[e] = cw[2048 + c0 + e]; }
    float p[6][8];
#pragma unroll
    for (int k = 0; k < 6; ++k) { const int t = t0 - 2 + k;
      if (k < 2 && first) {
#pragma unroll
        for (int e = 0; e < 8; ++e) p[k][e] = 0.f;
      } else { const u32x4 gp = *(const u32x4*)(Pu + (size_t)t * PW + 4096 + c0);
#pragma unroll
        for (int e = 0; e < 4; ++e) { p[k][2 * e] = __uint_as_float(gp[e] << 16); p[k][2 * e + 1] = __uint_as_float(gp[e] & 0xffff0000u); } } }
#pragma unroll
    for (int i = 0; i < 4; ++i) { const u32x4 gb = *(const u32x4*)(Pu + (size_t)(t0 + i) * PW + 3072 + c0); float r[8];
#pragma unroll
      for (int e = 0; e < 4; ++e) { r[2 * e] = __uint_as_float(gb[e] << 16) * (w0[2 * e] * p[i][2 * e] + w1[2 * e] * p[i + 1][2 * e] + w2[2 * e] * p[i + 2][2 * e]);
        r[2 * e + 1] = __uint_as_float(gb[e] & 0xffff0000u) * (w0[2 * e + 1] * p[i][2 * e + 1] + w1[2 * e + 1] * p[i + 1][2 * e + 1] + w2[2 * e + 1] * p[i + 2][2 * e + 1]); }
      u32x4 o; o.x = cvtpk(r[0], r[1]); o.y = cvtpk(r[2], r[3]); o.z = cvtpk(r[4], r[5]); o.w = cvtpk(r[6], r[7]);
      *(u32x4*)(Mu + (size_t)(t0 + i) * DMODEL + 1024 + c0) = o; } }
}
template <bool FIXED> __device__ __forceinline__ void attn_unit(int b, int h, int qb, const bf16* __restrict__ P, bf16* __restrict__ MIX, const float* __restrict__ BT, const float* __restrict__ subg,
                                          float lam, float post, float sref, const float* __restrict__ cw, int conv_base, char* lds) {
  int tid_ = threadIdx.x; asm volatile("" : "+v"(tid_));
  const int tid = tid_, lane = tid & 63, r32 = lane & 31, hi = lane >> 5;
  const int wid = __builtin_amdgcn_readfirstlane(tid >> 6), m = wid >> 2, wq = wid & 3;
  const long rowbase = (long)b * SEQ; const int q0 = qb * QB, qw0 = q0 + wq * 32;
  float* ws = (float*)(lds + LDS_WS) + wid * 64; float* li_l = ws; float* al_l = ws + 32;
  float* btl = (float*)(lds + LDS_BT);
  for (int i = tid; i < 768; i += 512) btl[i] = BT[(size_t)h * 768 + i] - (FIXED ? sref : 0.f);
  const float* bt = btl + m * 384 + 128;
  const float c31 = BT[(size_t)h * 768 + m * 384 + 128 + 127] - (FIXED ? sref : 0.f);
  f32x16 cfar, czero = f32x16{};
#pragma unroll
  for (int r = 0; r < 16; ++r) cfar[r] = FIXED ? c31 : 0.f;
  float m_reg = -1e30f, l_reg = 0.f; f32x16 o[4] = {}; bf16x8 qr[4];
  const bf16* Qw = P + (rowbase + qw0 + r32) * PW + h * 128 + m * 64 + hi * 8;
#pragma unroll
  for (int d0 = 0; d0 < 4; ++d0) qr[d0] = *reinterpret_cast<const bf16x8*>(Qw + d0 * 16);
  const bf16* Kh = P + rowbase * PW + 1024 + h * 128; const bf16* Vh = P + rowbase * PW + 2048 + h * 128;
  unsigned ksrc[2], vsrc[2];
#pragma unroll
  for (int i = 0; i < 2; ++i) { const int pk = wid * 2 + i;
    { const int row = 4 * pk + (lane >> 4), cc = lane & 15; ksrc[i] = (unsigned)(row * PW + ((cc ^ (row & 7)) * 8)); }
    { const int ob = pk * 1024 + lane * 16, sub = ob >> 9, kk = (sub >> 2) * 8 + ((ob & 511) >> 6), k = (kk & ~0xC) | ((kk & 4) << 1) | ((kk & 8) >> 1), c = (sub & 3) * 32 + ((ob & 63) >> 1);
      vsrc[i] = (unsigned)(k * PW + c); } }
  typedef __attribute__((address_space(3))) unsigned lds_u32;
  typedef __attribute__((address_space(3))) unsigned char lds_u8;
  lds_u8* const ring = (lds_u8*)lds + wid * 2048;
#define DMA_TILE(t, slot) do { const bf16* kg_ = Kh + (long)(t) * KVBLK * PW; const bf16* vg_ = Vh + (long)(t) * KVBLK * PW; \
    _Pragma("unroll") for (int i_ = 0; i_ < 2; ++i_) { \
      __builtin_amdgcn_global_load_lds((const unsigned*)(kg_ + ksrc[i_]), (lds_u32*)(ring + (slot) * SLOTB + i_ * 1024), 16, 0, 0); \
      __builtin_amdgcn_global_load_lds((const unsigned*)(vg_ + vsrc[i_]), (lds_u32*)(ring + (slot) * SLOTB + SHM_K + i_ * 1024), 16, 0, 0); } } while (0)
#define WAIT_BAR(N) asm volatile("s_waitcnt vmcnt(" #N ") lgkmcnt(0)\n\ts_barrier" ::: "memory")
  const lds_cptr vp0 = (lds_cptr)lds + SHM_K + v_rd_base(lane);
#define RESC(a) do { if (__any((a) < 1.f)) { if (hi == 0) al_l[r32] = (a); asm volatile("s_waitcnt lgkmcnt(0)" ::: "memory"); \
    _Pragma("unroll") for (int d = 0; d < 4; ++d) _Pragma("unroll") for (int r = 0; r < 16; ++r) o[d][r] *= al_l[crow(r, hi)]; } } while (0)
#define SCORE(P0, P1, Kbuf, t, CADD) do { const int dmin_ = qw0 - 64 * (t) - 63; const bool far_ = dmin_ >= 113; CADD = (far_ && !FIXED) ? c31 : 0.f; \
    if (FIXED && far_) { qkt(P0, P1, Kbuf, qr, r32, hi, m, cfar); } \
    else { qkt(P0, P1, Kbuf, qr, r32, hi, m, czero); if (!far_) bias_mask(P0, P1, bt, qw0 + r32 - 64 * (t) - 4 * hi); } } while (0)
  f32x16 p0, p1; float al, ca; bf16x8 pa0, pa1, pa2, pa3; const int NT = 2 * qb + 2;
#ifndef ATT_REP
#define ATT_REP 1
#endif
  const int NTT = ATT_REP * NT;
  DMA_TILE(0, 0); DMA_TILE(1, 1);
  WAIT_BAR(4);
  int slot = 0;
  for (int tt = 0; tt < NTT; ++tt) {
    const int t = (ATT_REP == 1) ? tt : (tt % NT), t2 = (ATT_REP == 1) ? tt + 2 : ((tt + 2) % NT);
    const int s2 = (slot >= 1) ? slot - 1 : 2;
    if (tt + 2 < NTT) DMA_TILE(t2, s2);
    SBAR();
#ifndef ATT_CREP
#define ATT_CREP 1
#endif
#pragma unroll 1
    for (int crep = 0; crep < ATT_CREP; ++crep) {
    SCORE(p0, p1, lds + slot * SLOTB, t, ca);
    if constexpr (FIXED) {
#pragma unroll
      for (int r = 0; r < 16; ++r) p0[r] = __builtin_amdgcn_exp2f(p0[r]);
      finishSM(p0, p1, 1.f, l_reg, pa0, pa1, pa2, pa3); SBAR();
    } else {
      partialSM(p0, p1, m_reg, al, ca);
      RESC(al);
      finishSM(p0, p1, al, l_reg, pa0, pa1, pa2, pa3); SBAR();
    }
    pv_all(o, vp0 + slot * SLOTB, pa0, pa1, pa2, pa3);
    }
    if (tt + 2 < NTT) WAIT_BAR(4); else WAIT_BAR(0);
    slot = (slot == 2) ? 0 : slot + 1;
  }
  if (hi == 0) li_l[r32] = l_reg; asm volatile("s_waitcnt lgkmcnt(0)" ::: "memory");
  float rli[16];
#pragma unroll
  for (int r = 0; r < 16; ++r) rli[r] = __builtin_amdgcn_rcpf(li_l[crow(r, hi)]);
  __syncthreads();
  float* xch = (float*)lds + wq * 4096 + lane;
  if (m == 1) {
#pragma unroll
    for (int d0 = 0; d0 < 4; ++d0)
#pragma unroll
      for (int r = 0; r < 16; ++r) xch[(d0 * 16 + r) * 64] = o[d0][r] * rli[r] * lam;
  }
  __syncthreads();
  if (m == 0) {
    bf16* Ow = MIX + (rowbase + qw0) * DMODEL + h * 128 + r32;
    float gsub[4];
#pragma unroll
    for (int d0 = 0; d0 < 4; ++d0) gsub[d0] = subg[d0 * 32 + r32] * post;
#pragma unroll
    for (int r = 0; r < 16; ++r) { float y[4]; float ss = 0.f;
#pragma unroll
      for (int d0 = 0; d0 < 4; ++d0) { y[d0] = o[d0][r] * rli[r] - xch[(d0 * 16 + r) * 64]; ss += y[d0] * y[d0]; }
      ss += __shfl_xor(ss, 1); ss += __shfl_xor(ss, 2); ss += __shfl_xor(ss, 4); ss += __shfl_xor(ss, 8); ss += __shfl_xor(ss, 16);
      const float rs = 1.0f / sqrtf(ss * (1.0f / 128.0f) + 1e-6f);
#pragma unroll
      for (int d0 = 0; d0 < 4; ++d0) Ow[(long)crow(r, hi) * DMODEL + d0 * 32] = __float2bfloat16(y[d0] * rs * gsub[d0]); }
  }
  if (m == 1) conv_item(P, MIX, cw, conv_base + wq, lane);
  __syncthreads();
#undef DMA_TILE
#undef WAIT_BAR
#undef RESC
#undef SCORE
}
#undef KSWZ
#undef SBAR
}
#ifndef DUP
#define DUP 0
#endif
#ifndef NO_CONV
#define NO_CONV 0
#endif
#ifndef NO_ATTU
#define NO_ATTU 0
#endif
#ifndef NO_P0
#define NO_P0 0
#endif
#ifndef NO_PROJ
#define NO_PROJ 0
#endif
#ifndef NO_ATT
#define NO_ATT 0
#endif
#ifndef NO_OUT
#define NO_OUT 0
#endif
#ifndef NO_UP
#define NO_UP 0
#endif
#ifndef NO_DN
#define NO_DN 0
#endif
#ifndef MK_PER_PHASE
#define MK_PER_PHASE 0
#endif
constexpr int NWAVES = 8;
constexpr int BATCH = 4, SEQ = 2048, T = BATCH * SEQ, D = 2048, PW = 6144, FF = 8192, NH = 8, DEPTH = 4, CONVW = 1024;
constexpr int N_PHASES = 1 + 5 * DEPTH;
constexpr size_t MiB = 1u << 20;
constexpr size_t WS_SSQ = 674 * MiB;
constexpr size_t WS_CTL = 0, CTL_ZERO_BYTES = 64 * 1024;
constexpr size_t WS_BT = 512 * 1024;
constexpr size_t WS_WIN = 2 * MiB, WS_WOUT = 98 * MiB, WS_WUP = 130 * MiB, WS_WDN = 258 * MiB;
constexpr size_t WS_XB = 386 * MiB, WS_PROJ = 418 * MiB, WS_MIX = 514 * MiB, WS_U = 546 * MiB, WS_END = 684 * MiB;
constexpr int LDS_BYTES = 147456, LDS_BARST = LDS_BYTES - 64;
#define LAS __attribute__((address_space(3)))
#define XB_TMO      128
#define XB_XCNT(j)  (256  + 64 * (j))
#define XB_XSUB(j)  (1280 + 64 * (j))
#define XB_XGEN(j)  (2304 + 64 * (j))
#define XB_TOP      3328
#define XB_TOPGEN   3392
#define XCD_BAR_WORDS 3456
#define XB_SPIN_CAP (1u << 18)

__device__ __forceinline__ unsigned xb_ld(unsigned* p)              { return __hip_atomic_load(p, __ATOMIC_RELAXED, __HIP_MEMORY_SCOPE_AGENT); }
__device__ __forceinline__ unsigned xb_add(unsigned* p, unsigned v) { return __hip_atomic_fetch_add(p, v, __ATOMIC_RELAXED, __HIP_MEMORY_SCOPE_AGENT); }
__device__ __forceinline__ unsigned xb_xcc_id() { return (unsigned)__builtin_amdgcn_s_getreg((3 << 11) | 20) & 0xFu; }
#define XB_SPIN(cond, bar) do { unsigned _sp = 0; while (cond) { __builtin_amdgcn_s_sleep(1); \
    if ((++_sp & 255u) == 0u) { if (xb_ld(&(bar)[XB_TMO])) break; if (_sp > XB_SPIN_CAP) { atomicAdd(&(bar)[XB_TMO], 1u); break; } } } } while (0)

struct XcdBarrier {
    unsigned* bar; unsigned x;
    volatile LAS unsigned* st;
};

__device__ __forceinline__ XcdBarrier xcd_barrier_post(unsigned* bar, volatile LAS unsigned* st) {
    XcdBarrier b; b.bar = bar; b.x = xb_xcc_id(); b.st = st;
    if (threadIdx.x == 0) (void)xb_add(&bar[XB_XCNT(b.x)], 1u);
    return b;
}
__device__ __forceinline__ void xcd_barrier_complete(unsigned* bar, unsigned x, unsigned& nloc, unsigned& nx) {
    const unsigned G = gridDim.x * gridDim.y * gridDim.z;
    unsigned sum, cnt, mine, sp = 0u;
    for (;;) {
        sum = 0u; cnt = 0u; mine = 0u;
#pragma unroll
        for (unsigned j = 0; j < 16; ++j) { const unsigned c = xb_ld(&bar[XB_XCNT(j)]); sum += c; cnt += (c > 0u) ? 1u : 0u; mine = (j == x) ? c : mine; }
        if (sum == G) break;
        __builtin_amdgcn_s_sleep(1);
        if ((++sp & 255u) == 0u) { if (xb_ld(&bar[XB_TMO])) break; if (sp > XB_SPIN_CAP) { atomicAdd(&bar[XB_TMO], 1u); break; } }
    }
    nloc = mine > 0u ? mine : 1u; nx = cnt > 0u ? cnt : 1u;
}

__device__ __forceinline__ void xcd_barrier(const XcdBarrier& b) {
    asm volatile("s_waitcnt vmcnt(0)" ::: "memory");
    __syncthreads();
    if (threadIdx.x == 0) {
        unsigned* bar = b.bar;
        __builtin_amdgcn_s_waitcnt(0);
        unsigned nloc = b.st[0], nx = b.st[1];
        if (nloc == 0u) { xcd_barrier_complete(bar, b.x, nloc, nx); b.st[0] = nloc; b.st[1] = nx; }
        const unsigned old = xb_add(&bar[XB_XSUB(b.x)], 1u);
        const unsigned gen = old / nloc;
        if (old + 1u == (gen + 1u) * nloc) {
            __builtin_amdgcn_fence(__ATOMIC_RELEASE, "agent");
            asm volatile("s_waitcnt vmcnt(0)" ::: "memory");
            const unsigned og = xb_add(&bar[XB_TOP], 1u);
            const unsigned tg = og / nx;
            if (og + 1u == (tg + 1u) * nx) xb_add(&bar[XB_TOPGEN], 1u);
            else XB_SPIN(xb_ld(&bar[XB_TOPGEN]) == tg, bar);
            __builtin_amdgcn_fence(__ATOMIC_ACQUIRE, "agent");
            xb_add(&bar[XB_XGEN(b.x)], 1u);
            asm volatile("s_waitcnt vmcnt(0)" ::: "memory");
        } else {
            XB_SPIN(xb_ld(&bar[XB_XGEN(b.x)]) == gen, bar);
            __builtin_amdgcn_fence(__ATOMIC_ACQUIRE, "agent");
            asm volatile("s_waitcnt vmcnt(0)" ::: "memory");
        }
    }
    __syncthreads();
}

typedef unsigned short bf16;
typedef unsigned v4u __attribute__((ext_vector_type(4)));
typedef float f32x4 __attribute__((ext_vector_type(4)));
__device__ __forceinline__ unsigned f2bf(float f) { unsigned u = __builtin_bit_cast(unsigned, f); return (u + 0x7fffu + ((u >> 16) & 1u)) >> 16; }
__device__ __forceinline__ unsigned pk2(float lo, float hi) { return f2bf(lo) | (f2bf(hi) << 16); }
__device__ __forceinline__ float wave_sum(float v) {
#pragma unroll
    for (int o = 1; o < 64; o <<= 1) v += __shfl_xor(v, o);
    return v;
}
__device__ __forceinline__ int win_row(int n) {
    if (n >= 4096) { const int isci = n >= 5120 ? 1 : 0, ch = n - (isci ? 5120 : 4096); return (16 + (ch >> 7)) * 256 + isci * 128 + (ch & 127); }
    const int c = n & 255; return (n & ~255) + ((c >> 5) & 1) * 128 + (c >> 6) * 32 + (c & 31); }
struct TItem { const float* src; const float* g; bf16* dst; int N, K, perm; };
__device__ __forceinline__ void titem_load(const TItem& d, f32x4 (&v)[16], float (&gg)[16], int lane) {
#pragma unroll
    for (int i = 0; i < 16; ++i) { const int kk = 32 * (i >> 3) + 8 * (lane >> 4) + (i & 7); v[i] = *(const f32x4*)(d.src + (size_t)kk * d.N + (lane & 15) * 4); gg[i] = d.g ? d.g[kk] : 1.f; }
}
__device__ __forceinline__ void titem_process(const TItem& d, const f32x4 (&v)[16], const float (&gg)[16], int lane) {
    const int n0 = d.perm >> 1;
#pragma unroll
    for (int j = 0; j < 4; ++j) { const int n = n0 + 4 * (lane & 15) + j, nr = (d.perm & 1) ? win_row(n) : n;
        bf16* rowp = d.dst + (size_t)(nr >> 8) * (d.K >> 6) * (256 * 64);
#pragma unroll
        for (int h = 0; h < 2; ++h) { v4u o;
            o.x = pg8::cvt_pk_bf16(v[8 * h + 0][j] * gg[8 * h + 0], v[8 * h + 1][j] * gg[8 * h + 1]); o.y = pg8::cvt_pk_bf16(v[8 * h + 2][j] * gg[8 * h + 2], v[8 * h + 3][j] * gg[8 * h + 3]);
            o.z = pg8::cvt_pk_bf16(v[8 * h + 4][j] * gg[8 * h + 4], v[8 * h + 5][j] * gg[8 * h + 5]); o.w = pg8::cvt_pk_bf16(v[8 * h + 6][j] * gg[8 * h + 6], v[8 * h + 7][j] * gg[8 * h + 7]);
            *(v4u*)(rowp + pg8::blk_off(nr & 255, 8 * (lane >> 4) + 32 * h)) = o; } }
}
__device__ __forceinline__ int t5_bucket(int d) {
    if (d < 16) return d;
    const int th[15] = {19, 21, 24, 27, 31, 35, 40, 46, 52, 59, 67, 77, 87, 99, 113};
    int b = 16;
#pragma unroll
    for (int i = 0; i < 15; ++i) b += (d >= th[i]) ? 1 : 0;
    return b;
}
struct Args { const float* in[18]; int ph_lo, ph_hi; };

__global__ void __launch_bounds__(NWAVES * 64, 2) hybrid_fwd(Args args) {
    extern __shared__ __attribute__((aligned(16))) unsigned char lds[];
    cg::grid_group grid = cg::this_grid();
    const int tid = threadIdx.x, lane = tid & 63, wave = __builtin_amdgcn_readfirstlane(tid >> 6);
    const int G = gridDim.x, bx = blockIdx.x;
    const int vcu = (G % 8 == 0) ? (bx % 8) * (G / 8) + bx / 8 : bx;
    const int lo = args.ph_lo, hi = args.ph_hi;
    if (tid < 16) ((volatile LAS unsigned*)((LAS unsigned char*)lds + LDS_BARST))[tid] = 0u;
    __syncthreads();
    const XcdBarrier xbar = xcd_barrier_post((unsigned*)args.in[17], (volatile LAS unsigned*)((LAS unsigned char*)lds + LDS_BARST));
#define IN(k) (lo <= (k) && (k) < hi)
#ifdef NO_SYNC
#define SEAM(k) do { } while (0)
#else
#define SEAM(k) do { if ((k) + 1 < hi) { if ((k) == 0) grid.sync(); else xcd_barrier(xbar); if (DUP & 16) { xcd_barrier(xbar); xcd_barrier(xbar); } } } while (0)
#endif

    for (int rep = 0; rep < ((DUP & 1) ? 2 : 1); ++rep)
    if (IN(0) && !NO_P0) {
        int z = 0; asm volatile("" : "+s"(z));
        unsigned char* ws = (unsigned char*)args.in[z + 17]; float* ssq = (float*)(ws + WS_SSQ); float* BT = (float*)(ws + WS_BT); bf16* XB = (bf16*)(ws + WS_XB);
        const int gw = vcu * NWAVES + wave, NGW = G * NWAVES;
        constexpr int I_IN = (D / 64) * (PW / 64), I_OUT = (D / 64) * (D / 64), I_UP = (D / 64) * (FF / 64), I_DN = (FF / 64) * (D / 64), I_L = I_IN + I_OUT + I_UP + I_DN;
        const float* const w_in = args.in[z + 1]; const float* const w_out = args.in[z + 2]; const float* const w_up = args.in[z + 13]; const float* const w_dn = args.in[z + 14];
        const float* const g_attn = args.in[z + 11]; const float* const g_mlp = args.in[z + 12];
        auto decode = [&](int it) -> TItem {
            const int l = it / I_L; int r = it % I_L; TItem d;
            const float* W; bf16* WT; const float* g = nullptr; int K = D, N = D, perm = 0;
            if (r < I_IN) { W = w_in + (size_t)l * D * PW; WT = (bf16*)(ws + WS_WIN) + (size_t)l * PW * D; N = PW; g = g_attn + l * D; perm = 1; }
            else if ((r -= I_IN) < I_OUT) { W = w_out + (size_t)l * D * D; WT = (bf16*)(ws + WS_WOUT) + (size_t)l * D * D; }
            else if ((r -= I_OUT) < I_UP) { W = w_up + (size_t)l * D * FF; WT = (bf16*)(ws + WS_WUP) + (size_t)l * FF * D; N = FF; g = g_mlp + l * D; }
            else { r -= I_UP; W = w_dn + (size_t)l * FF * D; WT = (bf16*)(ws + WS_WDN) + (size_t)l * D * FF; K = FF; }
            const int nblk = N / 64, k0 = 64 * (r / nblk), n0 = 64 * (r % nblk);
            d.src = W + (size_t)k0 * N + n0; d.g = g ? g + k0 : nullptr; d.dst = WT + (size_t)(k0 >> 6) * (256 * 64); d.N = N; d.K = K; d.perm = perm | (n0 << 1);
            return d; };
        {
            int it = gw; f32x4 va[16]; float ga[16]; TItem d0;
            if (it < DEPTH * I_L) { d0 = decode(it); titem_load(d0, va, ga, lane); }
            while (it < DEPTH * I_L) {
                const int itn = it + NGW; f32x4 vb[16]; float gb[16]; TItem d1;
                if (itn < DEPTH * I_L) { d1 = decode(itn); titem_load(d1, vb, gb, lane); }
                titem_process(d0, va, ga, lane);
                if (itn < DEPTH * I_L) {
#pragma unroll
                    for (int i = 0; i < 16; ++i) { va[i] = vb[i]; ga[i] = gb[i]; }
                    d0 = d1; }
                it = itn;
            }
        }
        const int gt = bx * (NWAVES * 64) + tid, NGT = G * NWAVES * 64;
        for (int i = gt; i < 16 * 384; i += NGT) { const int hm = i / 384, d = i % 384 - 128;
            BT[i] = d < 0 ? -1e30f : args.in[z + 15][t5_bucket(d > 127 ? 127 : d) * 16 + hm] * 1.4426950408889634f; }
        const float* x = args.in[z + 0];
        for (int row = gw; row < T; row += NGW) {
            const f32x4* xr = (const f32x4*)(x + (size_t)row * D) + lane; float s = 0.f;
            bf16* const xbrow = XB + (size_t)(row >> 8) * (D / 64) * (256 * 64);
#pragma unroll
            for (int j = 0; j < 8; ++j) { const f32x4 v = xr[64 * j]; s += (v[0] * v[0] + v[1] * v[1]) + (v[2] * v[2] + v[3] * v[3]);
                { const int col = 256 * j + 4 * lane; *(unsigned long long*)(xbrow + (size_t)(col >> 6) * (256 * 64) + pg8::blk_off(row & 255, col & 63)) = (unsigned long long)pk2(v[0], v[1]) | ((unsigned long long)pk2(v[2], v[3]) << 32); } }
            s = wave_sum(s); if (lane < 32) ssq[(size_t)row * 32 + lane] = (lane == 0) ? s : 0.f;
        }
        SEAM(0);
    }

    for (int l = 0; l < DEPTH; ++l) {
        const int p0 = 1 + 5 * l;
        for (int rep = 0; rep < ((DUP & 2) ? 2 : 1); ++rep)
        if (IN(p0) && !NO_PROJ) {
            int ll = l, z = 0; asm volatile("" : "+s"(ll), "+s"(z));
            unsigned char* w = (unsigned char*)args.in[z + 17]; float* xout = (float*)args.in[z + 16];
            pg8::Gemm g{(const bf16*)(w + WS_XB), (const bf16*)(w + WS_WIN) + (size_t)ll * PW * D, T, PW, D, 1  }; pg8::StaticOrder S; S.init(T, PW, G, bx);
            pg8::EpiProj E{(bf16*)(w + WS_PROJ), (const float*)(w + WS_SSQ) + (size_t)(2 * ll) * T * 32, args.in[z + 4] + ll * 64, args.in[z + 5] + ll * 64, PW};
            pg8::gemm_phase<pg8::EpiProj, pg8::StaticOrder, true, true>((LAS unsigned char*)lds, g, S, E);
            SEAM(p0);
        }
        for (int rep = 0; rep < ((DUP & 4) ? 2 : 1); ++rep)
        if (IN(p0 + 1) && !NO_ATT) {
            int ll = l, z = 0; asm volatile("" : "+s"(ll), "+s"(z));
            unsigned char* w = (unsigned char*)args.in[z + 17]; float* xout = (float*)args.in[z + 16];
            const bf16* PROJ = (const bf16*)(w + WS_PROJ); bf16* MIX = (bf16*)(w + WS_MIX); const float* BT = (const float*)(w + WS_BT);
            const float lam_init = 0.8f - 0.6f * expf(-0.3f * (float)ll);
            float a = args.in[z + 6][ll * 64 + lane] * args.in[z + 7][ll * 64 + lane], b2 = args.in[z + 8][ll * 64 + lane] * args.in[z + 9][ll * 64 + lane];
            a = wave_sum(a); b2 = wave_sum(b2);
            const float lam = expf(a) - expf(b2) + lam_init;
            float gqm = fabsf(args.in[z + 4][ll * 64 + lane]), gkm = fabsf(args.in[z + 5][ll * 64 + lane]);
#pragma unroll
            for (int o = 1; o < 64; o <<= 1) { gqm = fmaxf(gqm, __shfl_xor(gqm, o)); gkm = fmaxf(gkm, __shfl_xor(gkm, o)); }
            const float gqk = gqm * gkm;
            for (int pr = vcu; pr < BATCH * NH * 8 && !NO_ATTU; pr += G) {
                const int bh = pr >> 3, s = pr & 7;
#pragma unroll 1
                for (int half = 0; half < 2; ++half)
                {   const int qb = half == 0 ? 15 - s : s, hh = bh % NH;
                    float bm = fmaxf(fmaxf(BT[hh * 768 + 128 + lane], BT[hh * 768 + 128 + 64 + lane]), fmaxf(BT[hh * 768 + 384 + 128 + lane], BT[hh * 768 + 384 + 128 + 64 + lane]));
#pragma unroll
                    for (int o = 1; o < 64; o <<= 1) bm = fmaxf(bm, __shfl_xor(bm, o));
                    const float sref = 11.8f * gqk + bm + 0.25f;
                    if (sref <= 40.f) att::attn_unit<true>(bh / NH, hh, qb, (const att::bf16*)PROJ, (att::bf16*)MIX, BT, args.in[z + 10] + ll * 128, lam, 1.0f - lam_init, sref, args.in[z + 3] + (size_t)ll * 3 * CONVW, pr * 8 + half * 4, (char*)lds);
                    else att::attn_unit<false>(bh / NH, hh, qb, (const att::bf16*)PROJ, (att::bf16*)MIX, BT, args.in[z + 10] + ll * 128, lam, 1.0f - lam_init, 0.f, args.in[z + 3] + (size_t)ll * 3 * CONVW, pr * 8 + half * 4, (char*)lds);
                }
            }
            SEAM(p0 + 1);
        }
        if (IN(p0 + 2) && !NO_OUT) {
            int ll = l, z = 0; asm volatile("" : "+s"(ll), "+s"(z));
            unsigned char* w = (unsigned char*)args.in[z + 17]; float* xout = (float*)args.in[z + 16];
            pg8::Gemm g{(const bf16*)(w + WS_MIX), (const bf16*)(w + WS_WOUT) + (size_t)ll * D * D, T, D, D, 0}; pg8::StaticOrder S; S.init(T, D, G, bx);
            pg8::EpiResid E{(ll == 0) ? args.in[z + 0] : (const float*)nullptr, (float*)nullptr, (bf16*)(w + WS_XB), (float*)(w + WS_SSQ) + (size_t)(2 * ll + 1) * T * 32, D};
            pg8::gemm_phase<pg8::EpiResid, pg8::StaticOrder, false, true>((LAS unsigned char*)lds, g, S, E);
            SEAM(p0 + 2);
        }
        for (int rep = 0; rep < ((DUP & 8) ? 2 : 1); ++rep)
        if (IN(p0 + 3) && !NO_UP) {
            int ll = l, z = 0; asm volatile("" : "+s"(ll), "+s"(z));
            unsigned char* w = (unsigned char*)args.in[z + 17]; float* xout = (float*)args.in[z + 16];
            pg8::Gemm g{(const bf16*)(w + WS_XB), (const bf16*)(w + WS_WUP) + (size_t)ll * FF * D, T, FF, D, 1  }; pg8::StaticOrder S; S.init(T, FF, G, bx);
            pg8::EpiUp E{(bf16*)(w + WS_U), (const float*)(w + WS_SSQ) + (size_t)(2 * ll + 1) * T * 32, FF};
            pg8::gemm_phase<pg8::EpiUp, pg8::StaticOrder, true, true>((LAS unsigned char*)lds, g, S, E);
            SEAM(p0 + 3);
        }
        if (IN(p0 + 4) && !NO_DN) {
            int ll = l, z = 0; asm volatile("" : "+s"(ll), "+s"(z));
            unsigned char* w = (unsigned char*)args.in[z + 17]; float* xout = (float*)args.in[z + 16];
            pg8::Gemm g{(const bf16*)(w + WS_U), (const bf16*)(w + WS_WDN) + (size_t)ll * D * FF, T, D, FF, 1  }; pg8::StaticOrder S; S.init(T, D, G, bx);
            pg8::EpiResid E{(const float*)nullptr, (ll == DEPTH - 1) ? xout : (float*)nullptr, (bf16*)(w + WS_XB), (float*)(w + WS_SSQ) + (size_t)(2 * ll + 2) * T * 32, D};
            pg8::gemm_phase<pg8::EpiResid, pg8::StaticOrder, false, true>((LAS unsigned char*)lds, g, S, E);
            SEAM(p0 + 4);
        }
    }
#undef IN
#undef SEAM
}

extern "C" void kernel_launch(void* const* d_in, const int* in_sizes, int n_in, void* d_out, int out_size, void* d_ws, size_t ws_size, hipStream_t stream) {
    static int grid = 0;
    if (grid == 0) {
        if (n_in != 16 || in_sizes[0] != T * D || out_size != T * D || ws_size < WS_END) { fprintf(stderr, "kernel_launch: unexpected shapes (n_in %d in0 %d out %d ws %zu); nothing launched\n", n_in, n_in > 0 ? in_sizes[0] : -1, out_size, ws_size); grid = -1; return; }
        int dev = 0, cus = 0, per_cu = 0;
        if (hipGetDevice(&dev) != hipSuccess || hipDeviceGetAttribute(&cus, hipDeviceAttributeMultiprocessorCount, dev) != hipSuccess) { fprintf(stderr, "kernel_launch: device query failed\n"); grid = -1; return; }
        if (hipFuncSetAttribute((const void*)hybrid_fwd, hipFuncAttributeMaxDynamicSharedMemorySize, LDS_BYTES) != hipSuccess) { fprintf(stderr, "kernel_launch: hipFuncSetAttribute failed\n"); grid = -1; return; }
        if (hipOccupancyMaxActiveBlocksPerMultiprocessor(&per_cu, (const void*)hybrid_fwd, NWAVES * 64, LDS_BYTES) != hipSuccess || per_cu < 1) { fprintf(stderr, "kernel_launch: occupancy query says %d blocks per CU\n", per_cu); per_cu = 1; }
        (void)hipGetLastError();
        grid = cus * per_cu;
        fprintf(stderr, "kernel_launch: grid %d (%d CUs x %d)\n", grid, cus, per_cu);
    }
    if (grid < 0) return;
    if (hipMemsetAsync((char*)d_ws + WS_CTL, 0, CTL_ZERO_BYTES, stream) != hipSuccess) { fprintf(stderr, "kernel_launch: hipMemsetAsync failed\n"); return; }
    Args a{};
    for (int i = 0; i < 16; ++i) a.in[i] = (const float*)d_in[i];
    a.in[16] = (const float*)d_out; a.in[17] = (const float*)d_ws;
#if MK_PER_PHASE
    for (int ph = 0; ph < N_PHASES; ++ph) { a.ph_lo = ph; a.ph_hi = ph + 1; hipLaunchKernelGGL(hybrid_fwd, dim3(grid), dim3(NWAVES * 64), LDS_BYTES, stream, a); }
#else
    a.ph_lo = 0; a.ph_hi = N_PHASES;
    void* kargs[] = {&a};
    const hipError_t e = hipLaunchCooperativeKernel((const void*)hybrid_fwd, dim3(grid), dim3(NWAVES * 64), kargs, LDS_BYTES, stream);
    if (e != hipSuccess) fprintf(stderr, "kernel_launch: cooperative launch failed: %s (grid %d)\n", hipGetErrorString(e), grid);
#endif
    const hipError_t le = hipPeekAtLastError();
    if (le != hipSuccess) fprintf(stderr, "kernel_launch: launch error %s\n", hipGetErrorName(le));
}
```

```cpp
#include <hip/hip_runtime.h>
#include <hip/hip_bf16.h>
#include <hip/hip_cooperative_groups.h>
#include <cstdio>
#include <cstdint>
#include <cmath>
namespace cg = cooperative_groups;
namespace pg8 {
#define PG8_LAS __attribute__((address_space(3)))
typedef unsigned short bf16_t;
typedef short bf16x8 __attribute__((ext_vector_type(8)));
typedef float f32x4 __attribute__((ext_vector_type(4)));
typedef unsigned u32x4 __attribute__((ext_vector_type(4)));
constexpr int BM = 256, BK = 64, HALF = 128, HTB = HALF * BK * 2  , STAGE_BYTES = 8 * HTB, NXCD = 8, WGM = 8;

__host__ __device__ __forceinline__ int lds_byte(int r, int c) { const int st = (r >> 4) * 2 + (c >> 5), rr = r & 15, cc = c & 31, ob = rr * 64 + cc * 2; return st * 1024 + (ob ^ (((ob >> 9) & 1) << 5)); }
__host__ __device__ __forceinline__ void stage_rc(int b, int& R, int& C) { const int st = b / 1024, sb = b % 1024, swz = sb ^ (((sb >> 9) & 1) << 5); R = (st >> 1) * 16 + swz / 64; C = (st & 1) * 32 + (swz % 64) / 2; }
__host__ __device__ __forceinline__ int perm32(int rho) { const int n = rho >> 4, i = rho & 15; return 8 * (i >> 2) + 4 * n + (i & 3); }

__host__ __device__ __forceinline__ int blk_off(int r, int c) { const int rr = r & 127; return (r >> 7) * 8192 + (((rr >> 4) * 2 + (c >> 5)) * 512) + (rr & 15) * 32 + (c & 31); }
struct Unit { int pm, pn; };
struct Gemm { const bf16_t* A; const bf16_t* Bt; int M, N, K; int a_blocked; };

struct StaticOrder {
    int nM, nN, nwg, G, c;
    __host__ __device__ void init(int M, int N, int G_, int c_) { nM = M / BM; nN = N / BM; nwg = nM * nN; G = G_; c = c_; }
    __host__ __device__ bool next(int i, Unit& u) const {
        const long L = (long)i * G + c; if (L >= nwg) return false;
        int wgid = (int)L; { const int q = nwg / NXCD, r = nwg % NXCD, xcd = wgid % NXCD, off = wgid / NXCD; wgid = (xcd < r ? xcd * (q + 1) : r * (q + 1) + (xcd - r) * q) + off; }
        const int nig = WGM * nN, gid = wgid / nig, fm = gid * WGM, gsz = (nM - fm) < WGM ? (nM - fm) : WGM;
        u.pm = fm + ((wgid % nig) % gsz); u.pn = (wgid % nig) / gsz; return true;
    }
    __device__ __forceinline__ void a_ready(const Unit&) const {}
    __device__ __forceinline__ void done(const Unit&) const {}
};

__device__ __forceinline__ unsigned cvt_pk_bf16(float lo, float hi) { unsigned r; asm volatile("v_cvt_pk_bf16_f32 %0, %1, %2" : "=v"(r) : "v"(lo), "v"(hi)); return r; }
typedef float f32x2 __attribute__((ext_vector_type(2)));
constexpr float RMS_EPS = 1e-6f;
constexpr float QC2 = 0.125f * 1.4426950408889634f;
typedef unsigned u32x2e __attribute__((ext_vector_type(2)));
__device__ __forceinline__ float row_rstd(const float* ssq, int row) {
    const f32x4* p = (const f32x4*)(ssq + (size_t)row * 32); f32x4 a = p[0];
#pragma unroll
    for (int i = 1; i < 8; ++i) a = a + p[i];
    return 1.0f / sqrtf(((a[0] + a[1]) + (a[2] + a[3])) * (1.0f / 2048.0f) + RMS_EPS);
}
__device__ __forceinline__ void zero_acc(f32x4 (&acc)[2][2][4][2]) {
#pragma unroll
    for (int a = 0; a < 2; ++a)
#pragma unroll
        for (int b = 0; b < 2; ++b)
#pragma unroll
            for (int m = 0; m < 4; ++m)
#pragma unroll
                for (int n = 0; n < 2; ++n) acc[a][b][m][n] = (f32x4){0.f, 0.f, 0.f, 0.f};
}
__device__ __forceinline__ void rows_rstd(float (&rs)[2][4], const float* ssq, int row0, int fq) {
    f32x4 pa[2][4], pb[2][4];
#pragma unroll
    for (int ai = 0; ai < 2; ++ai)
#pragma unroll
        for (int m = 0; m < 4; ++m) { const f32x4* p = (const f32x4*)(ssq + (size_t)(row0 + ai * HALF + m * 16) * 32 + 8 * fq); pa[ai][m] = p[0]; pb[ai][m] = p[1]; }
#pragma unroll
    for (int ai = 0; ai < 2; ++ai)
#pragma unroll
        for (int m = 0; m < 4; ++m) { const f32x4 a = pa[ai][m] + pb[ai][m]; float t = (a[0] + a[1]) + (a[2] + a[3]);
            t += __shfl_xor(t, 16); t += __shfl_xor(t, 32); rs[ai][m] = 1.0f / sqrtf(t * (1.0f / 2048.0f) + RMS_EPS); }
}
struct RsState { f32x4 ra, rb; int pm; };
struct NoState { int pm; };
struct EpiProj {
    typedef RsState State; static constexpr int KR = 1;
    static constexpr bool PERM = true, AFTER_DRAIN = false;
    bf16_t* O; const float* ssq; const float* qg; const float* kg; int ldc;
    __device__ __forceinline__ void init(f32x4 (&acc)[2][2][4][2], State& st, const Unit& u, int wr, int, int fr, int fq) const { zero_acc(acc);
        if (st.pm != u.pm) { float t[2][4]; rows_rstd(t, ssq, u.pm * BM + wr * 64 + fr, fq); st.ra = (f32x4){t[0][0], t[0][1], t[0][2], t[0][3]}; st.rb = (f32x4){t[1][0], t[1][1], t[1][2], t[1][3]}; st.pm = u.pm; } }
    __device__ __forceinline__ void operator()(const f32x4 (&acc)[2][2][4][2], const State& st, const Unit& u, int wr, int wc, int fr, int fq) const {
        const int row0 = u.pm * BM + wr * 64 + fr, col0 = u.pn * BM + wc * 64 + 8 * fq;
        const float rsv[2][4] = {{st.ra[0], st.ra[1], st.ra[2], st.ra[3]}, {st.rb[0], st.rb[1], st.rb[2], st.rb[3]}};
        const bool qk = u.pn < 8, isq = u.pn < 4;
        f32x4 g[2][2];
#pragma unroll
        for (int bj = 0; bj < 2; ++bj)
#pragma unroll
            for (int n = 0; n < 2; ++n) { g[bj][n] = (f32x4){1.f, 1.f, 1.f, 1.f};
                if (qk) { g[bj][n] = *(const f32x4*)((isq ? qg : kg) + 32 * bj + 8 * fq + 4 * n); if (isq) g[bj][n] = g[bj][n] * QC2; } }
#pragma unroll
        for (int ai = 0; ai < 2; ++ai)
#pragma unroll
            for (int m = 0; m < 4; ++m) { const int row = row0 + ai * HALF + m * 16;
                const float rs = rsv[ai][m];
                f32x4 v[2][2];
#pragma unroll
                for (int bj = 0; bj < 2; ++bj)
#pragma unroll
                    for (int n = 0; n < 2; ++n) v[bj][n] = acc[ai][bj][m][n] * rs;
                if (qk) { float s = 0.f;
#pragma unroll
                    for (int bj = 0; bj < 2; ++bj)
#pragma unroll
                        for (int n = 0; n < 2; ++n) { const f32x4 x = v[bj][n]; s += (x[0] * x[0] + x[1] * x[1]) + (x[2] * x[2] + x[3] * x[3]); }
                    s += __shfl_xor(s, 16); s += __shfl_xor(s, 32);
                    const float r = 1.0f / sqrtf(s * (1.0f / 64.0f) + RMS_EPS);
#pragma unroll
                    for (int bj = 0; bj < 2; ++bj)
#pragma unroll
                        for (int n = 0; n < 2; ++n) v[bj][n] = v[bj][n] * r * g[bj][n]; }
                if (u.pn >= 16) {
                    const f32x4 q0 = v[0][0] * v[1][0], q1 = v[0][1] * v[1][1];
                    u32x4 w; w.x = cvt_pk_bf16(q0[0], q0[1]); w.y = cvt_pk_bf16(q0[2], q0[3]); w.z = cvt_pk_bf16(q1[0], q1[1]); w.w = cvt_pk_bf16(q1[2], q1[3]);
                    *(u32x4*)(O + (size_t)row * ldc + 4096 + (u.pn - 16) * 128 + wc * 32 + 8 * fq) = w;
                } else {
                bf16_t* rowp = O + (size_t)row * ldc + col0;
#pragma unroll
                for (int bj = 0; bj < 2; ++bj) { u32x4 w; w.x = cvt_pk_bf16(v[bj][0][0], v[bj][0][1]); w.y = cvt_pk_bf16(v[bj][0][2], v[bj][0][3]); w.z = cvt_pk_bf16(v[bj][1][0], v[bj][1][1]); w.w = cvt_pk_bf16(v[bj][1][2], v[bj][1][3]);
                    *(u32x4*)(rowp + 32 * bj) = w; } } }
    }
};
struct EpiUp {
    typedef RsState State; static constexpr int KR = 1;
    static constexpr bool PERM = true, AFTER_DRAIN = false;
    bf16_t* O; const float* ssq; int ldc;
    __device__ __forceinline__ void init(f32x4 (&acc)[2][2][4][2], State& st, const Unit& u, int wr, int, int fr, int fq) const { zero_acc(acc);
        if (st.pm != u.pm) { float t[2][4]; rows_rstd(t, ssq, u.pm * BM + wr * 64 + fr, fq); st.ra = (f32x4){t[0][0], t[0][1], t[0][2], t[0][3]}; st.rb = (f32x4){t[1][0], t[1][1], t[1][2], t[1][3]}; st.pm = u.pm; } }
    __device__ __forceinline__ void operator()(const f32x4 (&acc)[2][2][4][2], const State& st, const Unit& u, int wr, int wc, int fr, int fq) const {
        const int row0 = u.pm * BM + wr * 64 + fr, col0 = u.pn * BM + wc * 32 + 8 * fq;
        const float rsv[2][4] = {{st.ra[0], st.ra[1], st.ra[2], st.ra[3]}, {st.rb[0], st.rb[1], st.rb[2], st.rb[3]}};
#pragma unroll
        for (int ai = 0; ai < 2; ++ai)
#pragma unroll
            for (int m = 0; m < 4; ++m) { const int row = row0 + ai * HALF + m * 16;
                const float rs = rsv[ai][m];
                bf16_t* rowp = O + (size_t)(row >> 8) * (ldc >> 6) * (256 * 64);
#pragma unroll
                for (int bj = 0; bj < 2; ++bj) { f32x4 v0 = acc[ai][bj][m][0] * rs, v1 = acc[ai][bj][m][1] * rs;
#pragma unroll
                    for (int e = 0; e < 4; ++e) { const float a = fmaxf(v0[e], 0.f), b = fmaxf(v1[e], 0.f); v0[e] = a * a; v1[e] = b * b; }
                    u32x4 w; w.x = cvt_pk_bf16(v0[0], v0[1]); w.y = cvt_pk_bf16(v0[2], v0[3]); w.z = cvt_pk_bf16(v1[0], v1[1]); w.w = cvt_pk_bf16(v1[2], v1[3]);
                    { const int col = col0 + bj * HALF; *(u32x4*)(rowp + (size_t)(col >> 6) * (256 * 64) + blk_off(row & 255, col & 63)) = w; } } }
    }
};
struct EpiResid {
    typedef NoState State; static constexpr int KR = 1;
    static constexpr bool PERM = true, AFTER_DRAIN = false;
    const float* xin_f; float* xout_f; bf16_t* xb; float* ssq; int ldc;
    __device__ __forceinline__ size_t xb_off(int row, int col) const { return ((size_t)(row >> 8) * (ldc >> 6) + (col >> 6)) * (256 * 64) + blk_off(row & 255, col & 63); }
    __device__ __forceinline__ void init(f32x4 (&acc)[2][2][4][2], State&, const Unit& u, int wr, int wc, int fr, int fq) const {
        const int row0 = u.pm * BM + wr * 64 + fr, col0 = u.pn * BM + wc * 32 + 8 * fq;
        if (xin_f) {
#pragma unroll
            for (int ai = 0; ai < 2; ++ai)
#pragma unroll
                for (int m = 0; m < 4; ++m) { const size_t off = (size_t)(row0 + ai * HALF + m * 16) * ldc + col0;
#pragma unroll
                    for (int bj = 0; bj < 2; ++bj)
#pragma unroll
                        for (int n = 0; n < 2; ++n) acc[ai][bj][m][n] = *(const f32x4*)(xin_f + off + bj * HALF + n * 4); }
        } else {
#pragma unroll
            for (int ai = 0; ai < 2; ++ai)
#pragma unroll
                for (int m = 0; m < 4; ++m) { const size_t off = (size_t)(row0 + ai * HALF + m * 16) * ldc + col0;
#pragma unroll
                    for (int bj = 0; bj < 2; ++bj) { const u32x4 w = *(const u32x4*)(xb + xb_off(row0 + ai * HALF + m * 16, col0 + bj * HALF));
                        acc[ai][bj][m][0] = (f32x4){__uint_as_float(w.x << 16), __uint_as_float(w.x & 0xffff0000u), __uint_as_float(w.y << 16), __uint_as_float(w.y & 0xffff0000u)};
                        acc[ai][bj][m][1] = (f32x4){__uint_as_float(w.z << 16), __uint_as_float(w.z & 0xffff0000u), __uint_as_float(w.w << 16), __uint_as_float(w.w & 0xffff0000u)}; } }
        }
    }
    __device__ __forceinline__ void operator()(const f32x4 (&acc)[2][2][4][2], const State&, const Unit& u, int wr, int wc, int fr, int fq) const {
        const int row0 = u.pm * BM + wr * 64 + fr, col0 = u.pn * BM + wc * 32 + 8 * fq;
        if (xout_f) {
#pragma unroll
            for (int ai = 0; ai < 2; ++ai)
#pragma unroll
                for (int m = 0; m < 4; ++m) { const size_t off = (size_t)(row0 + ai * HALF + m * 16) * ldc + col0;
#pragma unroll
                    for (int bj = 0; bj < 2; ++bj)
#pragma unroll
                        for (int n = 0; n < 2; ++n) *(f32x4*)(xout_f + off + bj * HALF + n * 4) = acc[ai][bj][m][n]; }
        } else {
#pragma unroll
            for (int ai = 0; ai < 2; ++ai)
#pragma unroll
                for (int m = 0; m < 4; ++m) { const int row = row0 + ai * HALF + m * 16; const size_t off = (size_t)row * ldc + col0; float ss = 0.f;
#pragma unroll
                    for (int bj = 0; bj < 2; ++bj) { const f32x4 v0 = acc[ai][bj][m][0], v1 = acc[ai][bj][m][1];
                        u32x4 w; w.x = cvt_pk_bf16(v0[0], v0[1]); w.y = cvt_pk_bf16(v0[2], v0[3]); w.z = cvt_pk_bf16(v1[0], v1[1]); w.w = cvt_pk_bf16(v1[2], v1[3]);
                        *(u32x4*)(xb + xb_off(row, col0 + bj * HALF)) = w;
                        ss += ((v0[0] * v0[0] + v0[1] * v0[1]) + (v0[2] * v0[2] + v0[3] * v0[3])) + ((v1[0] * v1[0] + v1[1] * v1[1]) + (v1[2] * v1[2] + v1[3] * v1[3])); }
                    ss += __shfl_xor(ss, 16); ss += __shfl_xor(ss, 32);
                    if (fq == 0) ssq[(size_t)row * 32 + u.pn * 4 + wc] = ss; }
        }
    }
};
#ifndef KREP
#define KREP 1
#endif
template <class Epi, class Sched, bool ALIGN_EPI = false, bool SP2 = false>
__device__ __forceinline__ void gemm_phase(PG8_LAS unsigned char* lds, const Gemm g, const Sched& S, const Epi& E) {
    int tid_ = threadIdx.x; asm volatile("" : "+v"(tid_));
    const int tid = tid_, wid = __builtin_amdgcn_readfirstlane(tid >> 6), lane = tid & 63, wr = wid >> 2, wc = wid & 3, fr = lane & 15, fq = lane >> 4;
    const int K = g.K, nt = K / BK;
    constexpr int KR = (KREP == 2) ? 2 : Epi::KR;
    const int Ka = g.a_blocked ? BK : g.K;
    unsigned voffA[2], voffB[2];
#pragma unroll
    for (int i = 0; i < 2; ++i) { int R, C; stage_rc(tid * 16 + i * 8192, R, C); const int Rb = Epi::PERM ? ((R & ~31) + perm32(R & 31)) : R;
        voffA[i] = g.a_blocked ? (unsigned)blk_off(R, C) * 2u : (unsigned)(R * Ka + C) * 2u; static_assert(Epi::PERM, "the weight copies are stored with the PERM row order baked in"); (void)Rb; voffB[i] = (unsigned)blk_off(R, C) * 2u; }
    const size_t kstep = (size_t)(BK * 2);
    const size_t hstep = (size_t)HALF * K * 2;
    const size_t kstepB = (size_t)(BM * BK * 2), hstepB = (size_t)(HALF * BK * 2);
    const size_t kstepA = g.a_blocked ? (size_t)(BM * BK * 2) : kstep, hstepA = g.a_blocked ? (size_t)(HALF * BK * 2) : hstep;
    const size_t tstep = 2 * hstep;
    const unsigned ldsw = (unsigned)wid * 1024u;
    const int aoff = lds_byte(wr * 64 + fr, fq * 8), boff = lds_byte(wc * 32 + fr, fq * 8);
#define PG8_SA(b, h) (((b) * 2 + (h)) * HTB)
#define PG8_SB(b, h) ((4 + (b) * 2 + (h)) * HTB)
#define PG8_STAGE(bufoff, gbase, voff) do { _Pragma("unroll") for (int _i = 0; _i < 2; ++_i) \
        __builtin_amdgcn_global_load_lds((const unsigned*)((const char*)(gbase) + (voff)[_i]), (PG8_LAS unsigned*)(lds + (bufoff) + ldsw + _i * 8192), 16, 0, 0); } while (0)
#define PG8_LDA(dst, b, h) do { _Pragma("unroll") for (int m = 0; m < 4; ++m) _Pragma("unroll") for (int k = 0; k < 2; ++k) dst[m][k] = *(const PG8_LAS bf16x8*)(lds + PG8_SA(b, h) + aoff + m * 2048 + k * 1024); } while (0)
#define PG8_LDB(dst, b, h) do { _Pragma("unroll") for (int n = 0; n < 2; ++n) _Pragma("unroll") for (int k = 0; k < 2; ++k) dst[n][k] = *(const PG8_LAS bf16x8*)(lds + PG8_SB(b, h) + boff + n * 2048 + k * 1024); } while (0)
#define PG8_MMA(ai, bj, At, Bt) do { __builtin_amdgcn_s_setprio(1); _Pragma("unroll") for (int m = 0; m < 4; ++m) _Pragma("unroll") for (int n = 0; n < 2; ++n) _Pragma("unroll") for (int k = 0; k < 2; ++k) \
        acc[ai][bj][m][n] = __builtin_amdgcn_mfma_f32_16x16x32_bf16(Bt[n][k], At[m][k], acc[ai][bj][m][n], 0, 0, 0); __builtin_amdgcn_s_setprio(0); } while (0)
#define PG8_WAIT_V(n) asm volatile("s_waitcnt vmcnt(" #n ")" ::: "memory")
#define PG8_WAIT_L(n) asm volatile("s_waitcnt lgkmcnt(" #n ")" ::: "memory")
#define PG8_BAR __builtin_amdgcn_s_barrier()
#define PG8_SCHED __builtin_amdgcn_sched_barrier(0)
    Unit cur, nxt; int ui = 0;
    if (!S.next(0, cur)) return;
    f32x4 acc[2][2][4][2];
    typename Epi::State est; est.pm = -1;
    E.init(acc, est, cur, wr, wc, fr, fq);
    bf16x8 At[4][2], B0[2][2], B1[2][2];
    const char* cA = (const char*)g.A + (size_t)cur.pm * tstep; const char* cB = (const char*)g.Bt + (size_t)cur.pn * tstep;
    S.a_ready(cur);
    if constexpr (SP2) {
        PG8_STAGE(PG8_SB(0, 0), cB, voffB); PG8_STAGE(PG8_SB(0, 1), cB + hstepB, voffB); PG8_STAGE(PG8_SA(0, 0), cA, voffA); PG8_STAGE(PG8_SA(0, 1), cA + hstepA, voffA);
        if (wr == 1) PG8_BAR;
        PG8_WAIT_V(2); PG8_BAR;
        PG8_STAGE(PG8_SB(1, 0), cB + kstepB, voffB); PG8_STAGE(PG8_SA(1, 0), cA + kstepA, voffA); PG8_STAGE(PG8_SB(1, 1), cB + hstepB + kstepB, voffB);
        PG8_WAIT_V(6); PG8_BAR;
    } else {
        PG8_STAGE(PG8_SB(0, 0), cB, voffB); PG8_STAGE(PG8_SA(0, 0), cA, voffA); PG8_STAGE(PG8_SB(0, 1), cB + hstepB, voffB); PG8_STAGE(PG8_SA(0, 1), cA + hstepA, voffA);
        if (wr == 1) PG8_BAR;
        PG8_WAIT_V(4); PG8_BAR;
        PG8_STAGE(PG8_SB(1, 0), cB + kstepB, voffB); PG8_STAGE(PG8_SA(1, 0), cA + kstepA, voffA); PG8_STAGE(PG8_SB(1, 1), cB + hstepB + kstepB, voffB);
        PG8_WAIT_V(6); PG8_BAR;
    }
    for (;;) {
        const bool has_next = S.next(ui + 1, nxt);
        const char* nA = has_next ? (const char*)g.A + (size_t)nxt.pm * tstep : cA; const char* nB = has_next ? (const char*)g.Bt + (size_t)nxt.pn * tstep : cB;
        for (int t0_ = 0; t0_ < KR * nt; t0_ += 2) {
            const bool last = (t0_ == KR * nt - 2); const int t = (KR == 1) ? t0_ : (t0_ % nt), t2_ = (KR == 1) ? t0_ + 2 : ((t0_ + 2) % nt);
            const char* a1 = cA + (size_t)(t + 1) * kstepA;
            const char* a2 = last ? nA : cA + (size_t)t2_ * kstepA; const char* b2 = last ? nB : cB + (size_t)t2_ * kstepB;
            const char* a3 = a2 + kstepA; const char* b3 = b2 + kstepB;
            if (last && has_next) S.a_ready(nxt);
            if constexpr (SP2) {
            PG8_LDB(B0, 0, 0); PG8_LDB(B1, 0, 1); PG8_SCHED; PG8_LDA(At, 0, 0); PG8_STAGE(PG8_SA(1, 1), a1 + hstepA, voffA);
            PG8_WAIT_V(8); PG8_WAIT_L(0); PG8_BAR; PG8_MMA(0, 0, At, B0); PG8_MMA(0, 1, At, B1); PG8_BAR; PG8_SCHED;
            PG8_LDA(At, 0, 1); PG8_STAGE(PG8_SB(0, 0), b2, voffB); PG8_STAGE(PG8_SB(0, 1), b2 + hstepB, voffB); PG8_STAGE(PG8_SA(0, 0), a2, voffA);
            PG8_WAIT_V(8); PG8_WAIT_L(0); PG8_BAR; PG8_MMA(1, 0, At, B0); PG8_MMA(1, 1, At, B1); PG8_BAR; PG8_SCHED;
            PG8_LDB(B0, 1, 0); PG8_LDB(B1, 1, 1); PG8_SCHED; PG8_LDA(At, 1, 0); PG8_STAGE(PG8_SA(0, 1), a2 + hstepA, voffA);
            PG8_WAIT_V(8); PG8_WAIT_L(0); PG8_BAR; PG8_MMA(0, 0, At, B0); PG8_MMA(0, 1, At, B1); PG8_BAR; PG8_SCHED;
            PG8_LDA(At, 1, 1); PG8_STAGE(PG8_SB(1, 0), b3, voffB); PG8_STAGE(PG8_SB(1, 1), b3 + hstepB, voffB); PG8_STAGE(PG8_SA(1, 0), a3, voffA);
            PG8_WAIT_V(8); PG8_WAIT_L(0); PG8_BAR; PG8_MMA(1, 0, At, B0); PG8_MMA(1, 1, At, B1); PG8_BAR; PG8_SCHED;
            } else {
            PG8_LDB(B0, 0, 0); PG8_SCHED; PG8_LDA(At, 0, 0); PG8_STAGE(PG8_SA(1, 1), a1 + hstepA, voffA);
            PG8_WAIT_L(8); PG8_BAR; PG8_WAIT_L(0); PG8_MMA(0, 0, At, B0); PG8_BAR; PG8_SCHED;
            PG8_LDB(B1, 0, 1); PG8_STAGE(PG8_SB(0, 0), b2, voffB);
            PG8_BAR; PG8_WAIT_L(0); PG8_MMA(0, 1, At, B1); PG8_BAR;
            PG8_LDA(At, 0, 1); PG8_STAGE(PG8_SA(0, 0), a2, voffA);
            PG8_BAR; PG8_WAIT_L(0); PG8_MMA(1, 0, At, B0); PG8_BAR; PG8_SCHED;
            PG8_STAGE(PG8_SB(0, 1), b2 + hstepB, voffB);
            PG8_WAIT_V(6); PG8_BAR; PG8_MMA(1, 1, At, B1); PG8_BAR;
            PG8_LDB(B0, 1, 0); PG8_SCHED; PG8_LDA(At, 1, 0); PG8_STAGE(PG8_SA(0, 1), a2 + hstepA, voffA);
            PG8_WAIT_L(8); PG8_BAR; PG8_WAIT_L(0); PG8_MMA(0, 0, At, B0); PG8_BAR; PG8_SCHED;
            PG8_LDB(B1, 1, 1); PG8_STAGE(PG8_SB(1, 0), b3, voffB);
            PG8_BAR; PG8_WAIT_L(0); PG8_MMA(0, 1, At, B1); PG8_BAR;
            PG8_LDA(At, 1, 1); PG8_STAGE(PG8_SA(1, 0), a3, voffA);
            PG8_BAR; PG8_WAIT_L(0); PG8_MMA(1, 0, At, B0); PG8_BAR; PG8_SCHED;
            PG8_STAGE(PG8_SB(1, 1), b3 + hstepB, voffB);
            PG8_WAIT_V(6); PG8_BAR; PG8_MMA(1, 1, At, B1); PG8_BAR;
            }
        }
        if constexpr (KR == 2) {
#pragma unroll
            for (int a = 0; a < 2; ++a)
#pragma unroll
                for (int b = 0; b < 2; ++b)
#pragma unroll
                    for (int m = 0; m < 4; ++m)
#pragma unroll
                        for (int n = 0; n < 2; ++n) acc[a][b][m][n] = acc[a][b][m][n] * 0.5f;
        }
        if constexpr (ALIGN_EPI) { if (wr == 0) PG8_BAR; }
        if constexpr (!Epi::AFTER_DRAIN) { E(acc, est, cur, wr, wc, fr, fq); S.done(cur); }
        if (!has_next) break;
        E.init(acc, est, nxt, wr, wc, fr, fq);
        cur = nxt; cA = nA; cB = nB; ++ui;
        if constexpr (ALIGN_EPI) { if (wr == 1) PG8_BAR; }
    }
    PG8_WAIT_V(0);
    if constexpr (!ALIGN_EPI) { if (wr == 0) PG8_BAR; }
    PG8_BAR;
    if constexpr (Epi::AFTER_DRAIN) { E.fused(acc, cur, wr, wc, fr, fq, lds, wid, lane); S.done(cur); }
#undef PG8_SA
#undef PG8_SB
#undef PG8_STAGE
#undef PG8_LDA
#undef PG8_LDB
#undef PG8_MMA
#undef PG8_WAIT_V
#undef PG8_WAIT_L
#undef PG8_BAR
#undef PG8_SCHED
}
}
namespace att {
using bf16 = __hip_bfloat16;
using bf16x8 = __attribute__((ext_vector_type(8))) short;
using s16x4 = __attribute__((ext_vector_type(4))) short;
using f32x16 = __attribute__((ext_vector_type(16))) float;
using u32x4 = __attribute__((ext_vector_type(4))) unsigned;
constexpr int SEQ = 2048, PW = 6144, DMODEL = 2048, KVBLK = 64, QB = 128;
constexpr int SHM_V = KVBLK * 128 * 2, SHM_K = KVBLK * 128 * 2;
constexpr int NSLOT = 3, SLOTB = SHM_K + SHM_V;
constexpr int LDS_WS = NSLOT * SLOTB, LDS_BT = LDS_WS + 8 * 64 * 4, LDS_END = LDS_BT + 2 * 384 * 4;
constexpr float THR2 = 8.0f;
#define KSWZ(row, colB) ((row) * 256 + ((colB) ^ (((row) & 7) << 4)))
#define SBAR() __builtin_amdgcn_sched_barrier(0)
__device__ __forceinline__ int crow(int r, int hi) { return (r & 3) + 8 * (r >> 2) + 4 * hi; }
__device__ __forceinline__ unsigned cvtpk(float lo, float hi) { unsigned r; asm volatile("v_cvt_pk_bf16_f32 %0, %1, %2" : "=v"(r) : "v"(lo), "v"(hi)); return r; }
__device__ __forceinline__ void partialSM(f32x16& p0, f32x16& p1, float& m_reg, float& alpha, float cadd) {
  float pmax = p0[0];
#pragma unroll
  for (int r = 1; r < 16; ++r) pmax = fmaxf(pmax, p0[r]);
#pragma unroll
  for (int r = 0; r < 16; ++r) pmax = fmaxf(pmax, p1[r]);
  { auto rr = __builtin_amdgcn_permlane32_swap(__float_as_uint(pmax), __float_as_uint(pmax), false, false);
    pmax = fmaxf(__uint_as_float(rr[0]), __uint_as_float(rr[1])) + cadd; }
  if (__builtin_expect(__all(pmax - m_reg <= THR2), 1)) { alpha = 1.f; }
  else { const float mn = fmaxf(m_reg, pmax); alpha = __builtin_amdgcn_exp2f(m_reg - mn); m_reg = mn; }
  const float sh = cadd - m_reg;
#pragma unroll
  for (int r = 0; r < 16; ++r) { p0[r] += sh; p1[r] += sh; }
#pragma unroll
  for (int r = 0; r < 16; ++r) p0[r] = __builtin_amdgcn_exp2f(p0[r]);
}
__device__ __forceinline__ void finishSM(f32x16& p0, f32x16& p1, float alpha, float& l_reg, bf16x8& pa0, bf16x8& pa1, bf16x8& pa2, bf16x8& pa3) {
#pragma unroll
  for (int r = 0; r < 16; ++r) p1[r] = __builtin_amdgcn_exp2f(p1[r]);
  float ps = 0;
#pragma unroll
  for (int r = 0; r < 16; ++r) ps += p0[r];
#pragma unroll
  for (int r = 0; r < 16; ++r) ps += p1[r];
  { auto rr = __builtin_amdgcn_permlane32_swap(__float_as_uint(ps), __float_as_uint(ps), false, false);
    ps = __uint_as_float(rr[0]) + __uint_as_float(rr[1]); }
  l_reg = l_reg * alpha + ps;
#define PK4(P, BASE, OUT) do { unsigned a0 = cvtpk(P[BASE + 0], P[BASE + 1]), a1 = cvtpk(P[BASE + 2], P[BASE + 3]);   \
    unsigned b0 = cvtpk(P[BASE + 4], P[BASE + 5]), b1 = cvtpk(P[BASE + 6], P[BASE + 7]);                              \
    auto r0 = __builtin_amdgcn_permlane32_swap(a0, b0, false, false); auto r1 = __builtin_amdgcn_permlane32_swap(a1, b1, false, false); \
    u32x4 w = {r0[0], r1[0], r0[1], r1[1]}; OUT = *reinterpret_cast<bf16x8*>(&w); } while (0)
  PK4(p0, 0, pa0); PK4(p0, 8, pa1); PK4(p1, 0, pa2); PK4(p1, 8, pa3);
#undef PK4
}
__device__ __forceinline__ void qkt(f32x16& p0, f32x16& p1, const char* Ks, const bf16x8* qr, int r32, int hi, int m, const f32x16& cinit) {
  bf16x8 kf[8];
#pragma unroll
  for (int d0 = 0; d0 < 4; ++d0) { const int cb = (m * 64 + d0 * 16 + hi * 8) * 2;
    kf[2 * d0] = *reinterpret_cast<const bf16x8*>(Ks + KSWZ(r32, cb)); kf[2 * d0 + 1] = *reinterpret_cast<const bf16x8*>(Ks + KSWZ(32 + r32, cb)); }
  SBAR();
  p0 = __builtin_amdgcn_mfma_f32_32x32x16_bf16(kf[0], qr[0], cinit, 0, 0, 0);
  p1 = __builtin_amdgcn_mfma_f32_32x32x16_bf16(kf[1], qr[0], cinit, 0, 0, 0);
#pragma unroll
  for (int d0 = 1; d0 < 4; ++d0) {
    p0 = __builtin_amdgcn_mfma_f32_32x32x16_bf16(kf[2 * d0], qr[d0], p0, 0, 0, 0);
    p1 = __builtin_amdgcn_mfma_f32_32x32x16_bf16(kf[2 * d0 + 1], qr[d0], p1, 0, 0, 0); }
  SBAR();
}
__device__ __forceinline__ void bias_mask(f32x16& p0, f32x16& p1, const float* bt, int base) {
#pragma unroll
  for (int r = 0; r < 16; ++r) { const int c = (r & 3) + 8 * (r >> 2); p0[r] += bt[base - c]; }
  SBAR();
#pragma unroll
  for (int r = 0; r < 16; ++r) { const int c = (r & 3) + 8 * (r >> 2); p1[r] += bt[base - c - 32]; }
}
__device__ __forceinline__ int v_st(int k, int c) { const int kk = (k & ~0xC) | ((k & 4) << 1) | ((k & 8) >> 1); return ((kk >> 3) * 4 + (c >> 5)) * 512 + ((kk & 7) * 32 + (c & 31)) * 2; }
__device__ __forceinline__ int v_rd_base(int lane) { return ((lane & 3) << 3) | (((lane >> 2) & 3) << 6) | (((lane >> 4) & 1) << 5) | (((lane >> 5) & 1) << 8); }
constexpr int v_rd_off(int d0, int ks, int half) { return d0 * 512 + ks * 4096 + half * 2048; }
typedef short v4i16_t __attribute__((ext_vector_type(4)));
typedef __attribute__((address_space(3))) const char* lds_cptr;
__device__ __forceinline__ s16x4 vtr(lds_cptr p) { return __builtin_bit_cast(s16x4, __builtin_amdgcn_ds_read_tr16_b64_v4i16((__attribute__((address_space(3))) v4i16_t*)p)); }
struct VFrag { s16x4 lo[4], hi[4]; };
template <int KS> __device__ __forceinline__ void v_read(VFrag& f, lds_cptr vp) {
#pragma unroll
  for (int d0 = 0; d0 < 4; ++d0) { f.lo[d0] = vtr(vp + v_rd_off(d0, KS, 0)); f.hi[d0] = vtr(vp + v_rd_off(d0, KS, 1)); }
}
__device__ __forceinline__ void pv_slice(f32x16* o, const VFrag& f, bf16x8 pa) {
#pragma unroll
  for (int d0 = 0; d0 < 4; ++d0) { const bf16x8 vf = (bf16x8){f.lo[d0][0], f.lo[d0][1], f.lo[d0][2], f.lo[d0][3], f.hi[d0][0], f.hi[d0][1], f.hi[d0][2], f.hi[d0][3]};
    o[d0] = __builtin_amdgcn_mfma_f32_32x32x16_bf16(pa, vf, o[d0], 0, 0, 0); }
}
__device__ __forceinline__ void pv_all(f32x16* o, lds_cptr vp, bf16x8 pa0, bf16x8 pa1, bf16x8 pa2, bf16x8 pa3) {
  VFrag fa, fb;
  v_read<0>(fa, vp); v_read<1>(fb, vp); SBAR();
  pv_slice(o, fa, pa0); SBAR(); v_read<2>(fa, vp); SBAR();
  pv_slice(o, fb, pa1); SBAR(); v_read<3>(fb, vp); SBAR();
  pv_slice(o, fa, pa2); SBAR();
  pv_slice(o, fb, pa3); SBAR();
}
__device__ __forceinline__ void conv_item(const bf16* __restrict__ P, bf16* __restrict__ MIX, const float* __restrict__ cw, int it, int lane) {
  const unsigned short* Pu = reinterpret_cast<const unsigned short*>(P); unsigned short* Mu = reinterpret_cast<unsigned short*>(MIX);
  const int t0 = it * 4; const bool first = (t0 % SEQ) == 0;
#pragma unroll
  for (int j = 0; j < 2; ++j) { const int c0 = j * 512 + lane * 8;
    float w0[8], w1[8], w2[8];
#pragma unroll
    for (int e = 0; e < 8; ++e) { w0[e] = cw[c0 + e]; w1[e] = cw[1024 + c0 + e]; w2[e] = cw[2048 + c0 + e]; }
    float p[6][8];
#pragma unroll
    for (int k = 0; k < 6; ++k) { const int t = t0 - 2 + k;
      if (k < 2 && first) {
#pragma unroll
        for (int e = 0; e < 8; ++e) p[k][e] = 0.f;
      } else { const u32x4 gp = *(const u32x4*)(Pu + (size_t)t * PW + 4096 + c0);
#pragma unroll
        for (int e = 0; e < 4; ++e) { p[k][2 * e] = __uint_as_float(gp[e] << 16); p[k][2 * e + 1] = __uint_as_float(gp[e] & 0xffff0000u); } } }
#pragma unroll
    for (int i = 0; i < 4; ++i) { const u32x4 gb = *(const u32x4*)(Pu + (size_t)(t0 + i) * PW + 3072 + c0); float r[8];
#pragma unroll
      for (int e = 0; e < 4; ++e) { r[2 * e] = __uint_as_float(gb[e] << 16) * (w0[2 * e] * p[i][2 * e] + w1[2 * e] * p[i + 1][2 * e] + w2[2 * e] * p[i + 2][2 * e]);
        r[2 * e + 1] = __uint_as_float(gb[e] & 0xffff0000u) * (w0[2 * e + 1] * p[i][2 * e + 1] + w1[2 * e + 1] * p[i + 1][2 * e + 1] + w2[2 * e + 1] * p[i + 2][2 * e + 1]); }
      u32x4 o; o.x = cvtpk(r[0], r[1]); o.y = cvtpk(r[2], r[3]); o.z = cvtpk(r[4], r[5]); o.w = cvtpk(r[6], r[7]);
      *(u32x4*)(Mu + (size_t)(t0 + i) * DMODEL + 1024 + c0) = o; } }
}
template <bool FIXED> __device__ __forceinline__ void attn_unit(int b, int h, int qb, const bf16* __restrict__ P, bf16* __restrict__ MIX, const float* __restrict__ BT, const float* __restrict__ subg,
                                          float lam, float post, float sref, const float* __restrict__ cw, int conv_base, char* lds) {
  int tid_ = threadIdx.x; asm volatile("" : "+v"(tid_));
  const int tid = tid_, lane = tid & 63, r32 = lane & 31, hi = lane >> 5;
  const int wid = __builtin_amdgcn_readfirstlane(tid >> 6), m = wid >> 2, wq = wid & 3;
  const long rowbase = (long)b * SEQ; const int q0 = qb * QB, qw0 = q0 + wq * 32;
  float* ws = (float*)(lds + LDS_WS) + wid * 64; float* li_l = ws; float* al_l = ws + 32;
  float* btl = (float*)(lds + LDS_BT);
  for (int i = tid; i < 768; i += 512) btl[i] = BT[(size_t)h * 768 + i] - (FIXED ? sref : 0.f);
  const float* bt = btl + m * 384 + 128;
  const float c31 = BT[(size_t)h * 768 + m * 384 + 128 + 127] - (FIXED ? sref : 0.f);
  f32x16 cfar, czero = f32x16{};
#pragma unroll
  for (int r = 0; r < 16; ++r) cfar[r] = FIXED ? c31 : 0.f;
  float m_reg = -1e30f, l_reg = 0.f; f32x16 o[4] = {}; bf16x8 qr[4];
  const bf16* Qw = P + (rowbase + qw0 + r32) * PW + h * 128 + m * 64 + hi * 8;
#pragma unroll
  for (int d0 = 0; d0 < 4; ++d0) qr[d0] = *reinterpret_cast<const bf16x8*>(Qw + d0 * 16);
  const bf16* Kh = P + rowbase * PW + 1024 + h * 128; const bf16* Vh = P + rowbase * PW + 2048 + h * 128;
  unsigned ksrc[2], vsrc[2];
#pragma unroll
  for (int i = 0; i < 2; ++i) { const int pk = wid * 2 + i;
    { const int row = 4 * pk + (lane >> 4), cc = lane & 15; ksrc[i] = (unsigned)(row * PW + ((cc ^ (row & 7)) * 8)); }
    { const int ob = pk * 1024 + lane * 16, sub = ob >> 9, kk = (sub >> 2) * 8 + ((ob & 511) >> 6), k = (kk & ~0xC) | ((kk & 4) << 1) | ((kk & 8) >> 1), c = (sub & 3) * 32 + ((ob & 63) >> 1);
      vsrc[i] = (unsigned)(k * PW + c); } }
  typedef __attribute__((address_space(3))) unsigned lds_u32;
  typedef __attribute__((address_space(3))) unsigned char lds_u8;
  lds_u8* const ring = (lds_u8*)lds + wid * 2048;
#define DMA_TILE(t, slot) do { const bf16* kg_ = Kh + (long)(t) * KVBLK * PW; const bf16* vg_ = Vh + (long)(t) * KVBLK * PW; \
    _Pragma("unroll") for (int i_ = 0; i_ < 2; ++i_) { \
      __builtin_amdgcn_global_load_lds((const unsigned*)(kg_ + ksrc[i_]), (lds_u32*)(ring + (slot) * SLOTB + i_ * 1024), 16, 0, 0); \
      __builtin_amdgcn_global_load_lds((const unsigned*)(vg_ + vsrc[i_]), (lds_u32*)(ring + (slot) * SLOTB + SHM_K + i_ * 1024), 16, 0, 0); } } while (0)
#define WAIT_BAR(N) asm volatile("s_waitcnt vmcnt(" #N ") lgkmcnt(0)\n\ts_barrier" ::: "memory")
  const lds_cptr vp0 = (lds_cptr)lds + SHM_K + v_rd_base(lane);
#define RESC(a) do { if (__any((a) < 1.f)) { if (hi == 0) al_l[r32] = (a); asm volatile("s_waitcnt lgkmcnt(0)" ::: "memory"); \
    _Pragma("unroll") for (int d = 0; d < 4; ++d) _Pragma("unroll") for (int r = 0; r < 16; ++r) o[d][r] *= al_l[crow(r, hi)]; } } while (0)
#define SCORE(P0, P1, Kbuf, t, CADD) do { const int dmin_ = qw0 - 64 * (t) - 63; const bool far_ = dmin_ >= 113; CADD = (far_ && !FIXED) ? c31 : 0.f; \
    if (FIXED && far_) { qkt(P0, P1, Kbuf, qr, r32, hi, m, cfar); } \
    else { qkt(P0, P1, Kbuf, qr, r32, hi, m, czero); if (!far_) bias_mask(P0, P1, bt, qw0 + r32 - 64 * (t) - 4 * hi); } } while (0)
  f32x16 p0, p1; float al, ca; bf16x8 pa0, pa1, pa2, pa3; const int NT = 2 * qb + 2;
#ifndef ATT_REP
#define ATT_REP 1
#endif
  const int NTT = ATT_REP * NT;
  DMA_TILE(0, 0); DMA_TILE(1, 1);
  WAIT_BAR(4);
  int slot = 0;
  for (int tt = 0; tt < NTT; ++tt) {
    const int t = (ATT_REP == 1) ? tt : (tt % NT), t2 = (ATT_REP == 1) ? tt + 2 : ((tt + 2) % NT);
    const int s2 = (slot >= 1) ? slot - 1 : 2;
    if (tt + 2 < NTT) DMA_TILE(t2, s2);
    SBAR();
#ifndef ATT_CREP
#define ATT_CREP 1
#endif
#pragma unroll 1
    for (int crep = 0; crep < ATT_CREP; ++crep) {
    SCORE(p0, p1, lds + slot * SLOTB, t, ca);
    if constexpr (FIXED) {
#pragma unroll
      for (int r = 0; r < 16; ++r) p0[r] = __builtin_amdgcn_exp2f(p0[r]);
      finishSM(p0, p1, 1.f, l_reg, pa0, pa1, pa2, pa3); SBAR();
    } else {
      partialSM(p0, p1, m_reg, al, ca);
      RESC(al);
      finishSM(p0, p1, al, l_reg, pa0, pa1, pa2, pa3); SBAR();
    }
    pv_all(o, vp0 + slot * SLOTB, pa0, pa1, pa2, pa3);
    }
    if (tt + 2 < NTT) WAIT_BAR(4); else WAIT_BAR(0);
    slot = (slot == 2) ? 0 : slot + 1;
  }
  if (hi == 0) li_l[r32] = l_reg; asm volatile("s_waitcnt lgkmcnt(0)" ::: "memory");
  float rli[16];
#pragma unroll
  for (int r = 0; r < 16; ++r) rli[r] = __builtin_amdgcn_rcpf(li_l[crow(r, hi)]);
  __syncthreads();
  float* xch = (float*)lds + wq * 4096 + lane;
  if (m == 1) {
#pragma unroll
    for (int d0 = 0; d0 < 4; ++d0)
#pragma unroll
      for (int r = 0; r < 16; ++r) xch[(d0 * 16 + r) * 64] = o[d0][r] * rli[r] * lam;
  }
  __syncthreads();
  if (m == 0) {
    bf16* Ow = MIX + (rowbase + qw0) * DMODEL + h * 128 + r32;
    float gsub[4];
#pragma unroll
    for (int d0 = 0; d0 < 4; ++d0) gsub[d0] = subg[d0 * 32 + r32] * post;
#pragma unroll
    for (int r = 0; r < 16; ++r) { float y[4]; float ss = 0.f;
#pragma unroll
      for (int d0 = 0; d0 < 4; ++d0) { y[d0] = o[d0][r] * rli[r] - xch[(d0 * 16 + r) * 64]; ss += y[d0] * y[d0]; }
      ss += __shfl_xor(ss, 1); ss += __shfl_xor(ss, 2); ss += __shfl_xor(ss, 4); ss += __shfl_xor(ss, 8); ss += __shfl_xor(ss, 16);
      const float rs = 1.0f / sqrtf(ss * (1.0f / 128.0f) + 1e-6f);
#pragma unroll
      for (int d0 = 0; d0 < 4; ++d0) Ow[(long)crow(r, hi) * DMODEL + d0 * 32] = __float2bfloat16(y[d0] * rs * gsub[d0]); }
  }
  if (m == 1) conv_item(P, MIX, cw, conv_base + wq, lane);
  __syncthreads();
#undef DMA_TILE
#undef WAIT_BAR
#undef RESC
#undef SCORE
}
#undef KSWZ
#undef SBAR
}
#ifndef DUP
#define DUP 0
#endif
#ifndef NO_CONV
#define NO_CONV 0
#endif
#ifndef NO_ATTU
#define NO_ATTU 0
#endif
#ifndef NO_P0
#define NO_P0 0
#endif
#ifndef NO_PROJ
#define NO_PROJ 0
#endif
#ifndef NO_ATT
#define NO_ATT 0
#endif
#ifndef NO_OUT
#define NO_OUT 0
#endif
#ifndef NO_UP
#define NO_UP 0
#endif
#ifndef NO_DN
#define NO_DN 0
#endif
#ifndef MK_PER_PHASE
#define MK_PER_PHASE 0
#endif
constexpr int NWAVES = 8;
constexpr int BATCH = 4, SEQ = 2048, T = BATCH * SEQ, D = 2048, PW = 6144, FF = 8192, NH = 8, DEPTH = 4, CONVW = 1024;
constexpr int N_PHASES = 1 + 5 * DEPTH;
constexpr size_t MiB = 1u << 20;
constexpr size_t WS_SSQ = 674 * MiB;
constexpr size_t WS_CTL = 0, CTL_ZERO_BYTES = 64 * 1024;
constexpr size_t WS_BT = 512 * 1024;
constexpr size_t WS_WIN = 2 * MiB, WS_WOUT = 98 * MiB, WS_WUP = 130 * MiB, WS_WDN = 258 * MiB;
constexpr size_t WS_XB = 386 * MiB, WS_PROJ = 418 * MiB, WS_MIX = 514 * MiB, WS_U = 546 * MiB, WS_END = 684 * MiB;
constexpr int LDS_BYTES = 147456, LDS_BARST = LDS_BYTES - 64;
#define LAS __attribute__((address_space(3)))
#define XB_TMO      128
#define XB_XCNT(j)  (256  + 64 * (j))
#define XB_XSUB(j)  (1280 + 64 * (j))
#define XB_XGEN(j)  (2304 + 64 * (j))
#define XB_TOP      3328
#define XB_TOPGEN   3392
#define XCD_BAR_WORDS 3456
#define XB_SPIN_CAP (1u << 18)

__device__ __forceinline__ unsigned xb_ld(unsigned* p)              { return __hip_atomic_load(p, __ATOMIC_RELAXED, __HIP_MEMORY_SCOPE_AGENT); }
__device__ __forceinline__ unsigned xb_add(unsigned* p, unsigned v) { return __hip_atomic_fetch_add(p, v, __ATOMIC_RELAXED, __HIP_MEMORY_SCOPE_AGENT); }
__device__ __forceinline__ unsigned xb_xcc_id() { return (unsigned)__builtin_amdgcn_s_getreg((3 << 11) | 20) & 0xFu; }
#define XB_SPIN(cond, bar) do { unsigned _sp = 0; while (cond) { __builtin_amdgcn_s_sleep(1); \
    if ((++_sp & 255u) == 0u) { if (xb_ld(&(bar)[XB_TMO])) break; if (_sp > XB_SPIN_CAP) { atomicAdd(&(bar)[XB_TMO], 1u); break; } } } } while (0)

struct XcdBarrier {
    unsigned* bar; unsigned x;
    volatile LAS unsigned* st;
};

__device__ __forceinline__ XcdBarrier xcd_barrier_post(unsigned* bar, volatile LAS unsigned* st) {
    XcdBarrier b; b.bar = bar; b.x = xb_xcc_id(); b.st = st;
    if (threadIdx.x == 0) (void)xb_add(&bar[XB_XCNT(b.x)], 1u);
    return b;
}
__device__ __forceinline__ void xcd_barrier_complete(unsigned* bar, unsigned x, unsigned& nloc, unsigned& nx) {
    const unsigned G = gridDim.x * gridDim.y * gridDim.z;
    unsigned sum, cnt, mine, sp = 0u;
    for (;;) {
        sum = 0u; cnt = 0u; mine = 0u;
#pragma unroll
        for (unsigned j = 0; j < 16; ++j) { const unsigned c = xb_ld(&bar[XB_XCNT(j)]); sum += c; cnt += (c > 0u) ? 1u : 0u; mine = (j == x) ? c : mine; }
        if (sum == G) break;
        __builtin_amdgcn_s_sleep(1);
        if ((++sp & 255u) == 0u) { if (xb_ld(&bar[XB_TMO])) break; if (sp > XB_SPIN_CAP) { atomicAdd(&bar[XB_TMO], 1u); break; } }
    }
    nloc = mine > 0u ? mine : 1u; nx = cnt > 0u ? cnt : 1u;
}

__device__ __forceinline__ void xcd_barrier(const XcdBarrier& b) {
    asm volatile("s_waitcnt vmcnt(0)" ::: "memory");
    __syncthreads();
    if (threadIdx.x == 0) {
        unsigned* bar = b.bar;
        __builtin_amdgcn_s_waitcnt(0);
        unsigned nloc = b.st[0], nx = b.st[1];
        if (nloc == 0u) { xcd_barrier_complete(bar, b.x, nloc, nx); b.st[0] = nloc; b.st[1] = nx; }
        const unsigned old = xb_add(&bar[XB_XSUB(b.x)], 1u);
        const unsigned gen = old / nloc;
        if (old + 1u == (gen + 1u) * nloc) {
            __builtin_amdgcn_fence(__ATOMIC_RELEASE, "agent");
            asm volatile("s_waitcnt vmcnt(0)" ::: "memory");
            const unsigned og = xb_add(&bar[XB_TOP], 1u);
            const unsigned tg = og / nx;
            if (og + 1u == (tg + 1u) * nx) xb_add(&bar[XB_TOPGEN], 1u);
            else XB_SPIN(xb_ld(&bar[XB_TOPGEN]) == tg, bar);
            __builtin_amdgcn_fence(__ATOMIC_ACQUIRE, "agent");
            xb_add(&bar[XB_XGEN(b.x)], 1u);
            asm volatile("s_waitcnt vmcnt(0)" ::: "memory");
        } else {
            XB_SPIN(xb_ld(&bar[XB_XGEN(b.x)]) == gen, bar);
            __builtin_amdgcn_fence(__ATOMIC_ACQUIRE, "agent");
            asm volatile("s_waitcnt vmcnt(0)" ::: "memory");
        }
    }
    __syncthreads();
}

typedef unsigned short bf16;
typedef unsigned v4u __attribute__((ext_vector_type(4)));
typedef float f32x4 __attribute__((ext_vector_type(4)));
__device__ __forceinline__ unsigned f2bf(float f) { unsigned u = __builtin_bit_cast(unsigned, f); return (u + 0x7fffu + ((u >> 16) & 1u)) >> 16; }
__device__ __forceinline__ unsigned pk2(float lo, float hi) { return f2bf(lo) | (f2bf(hi) << 16); }
__device__ __forceinline__ float wave_sum(float v) {
#pragma unroll
    for (int o = 1; o < 64; o <<= 1) v += __shfl_xor(v, o);
    return v;
}
__device__ __forceinline__ int win_row(int n) {
    if (n >= 4096) { const int isci = n >= 5120 ? 1 : 0, ch = n - (isci ? 5120 : 4096); return (16 + (ch >> 7)) * 256 + isci * 128 + (ch & 127); }
    const int c = n & 255; return (n & ~255) + ((c >> 5) & 1) * 128 + (c >> 6) * 32 + (c & 31); }
struct TItem { const float* src; const float* g; bf16* dst; int N, K, perm; };
__device__ __forceinline__ void titem_load(const TItem& d, f32x4 (&v)[16], float (&gg)[16], int lane) {
#pragma unroll
    for (int i = 0; i < 16; ++i) { const int kk = 32 * (i >> 3) + 8 * (lane >> 4) + (i & 7); v[i] = *(const f32x4*)(d.src + (size_t)kk * d.N + (lane & 15) * 4); gg[i] = d.g ? d.g[kk] : 1.f; }
}
__device__ __forceinline__ void titem_process(const TItem& d, const f32x4 (&v)[16], const float (&gg)[16], int lane) {
    const int n0 = d.perm >> 1;
#pragma unroll
    for (int j = 0; j < 4; ++j) { const int n = n0 + 4 * (lane & 15) + j, nr = (d.perm & 1) ? win_row(n) : n;
        const int w32 = nr & 31, nrs = (nr & 255 & ~31) + 16 * ((w32 >> 2) & 1) + 4 * (w32 >> 3) + (w32 & 3);
        bf16* rowp = d.dst + (size_t)(nr >> 8) * (d.K >> 6) * (256 * 64);
#pragma unroll
        for (int h = 0; h < 2; ++h) { v4u o;
            o.x = pg8::cvt_pk_bf16(v[8 * h + 0][j] * gg[8 * h + 0], v[8 * h + 1][j] * gg[8 * h + 1]); o.y = pg8::cvt_pk_bf16(v[8 * h + 2][j] * gg[8 * h + 2], v[8 * h + 3][j] * gg[8 * h + 3]);
            o.z = pg8::cvt_pk_bf16(v[8 * h + 4][j] * gg[8 * h + 4], v[8 * h + 5][j] * gg[8 * h + 5]); o.w = pg8::cvt_pk_bf16(v[8 * h + 6][j] * gg[8 * h + 6], v[8 * h + 7][j] * gg[8 * h + 7]);
            *(v4u*)(rowp + pg8::blk_off(nrs, 8 * (lane >> 4) + 32 * h)) = o; } }
}
__device__ __forceinline__ int t5_bucket(int d) {
    if (d < 16) return d;
    const int th[15] = {19, 21, 24, 27, 31, 35, 40, 46, 52, 59, 67, 77, 87, 99, 113};
    int b = 16;
#pragma unroll
    for (int i = 0; i < 15; ++i) b += (d >= th[i]) ? 1 : 0;
    return b;
}
struct Args { const float* in[18]; int ph_lo, ph_hi; };

__global__ void __launch_bounds__(NWAVES * 64, 2) hybrid_fwd(Args args) {
    extern __shared__ __attribute__((aligned(16))) unsigned char lds[];
    cg::grid_group grid = cg::this_grid();
    const int tid = threadIdx.x, lane = tid & 63, wave = __builtin_amdgcn_readfirstlane(tid >> 6);
    const int G = gridDim.x, bx = blockIdx.x;
    const int vcu = (G % 8 == 0) ? (bx % 8) * (G / 8) + bx / 8 : bx;
    const int lo = args.ph_lo, hi = args.ph_hi;
    if (tid < 16) ((volatile LAS unsigned*)((LAS unsigned char*)lds + LDS_BARST))[tid] = 0u;
    __syncthreads();
    const XcdBarrier xbar = xcd_barrier_post((unsigned*)args.in[17], (volatile LAS unsigned*)((LAS unsigned char*)lds + LDS_BARST));
#define IN(k) (lo <= (k) && (k) < hi)
#ifdef NO_SYNC
#define SEAM(k) do { } while (0)
#else
#define SEAM(k) do { if ((k) + 1 < hi) { if ((k) == 0) grid.sync(); else xcd_barrier(xbar); if (DUP & 16) { xcd_barrier(xbar); xcd_barrier(xbar); } } } while (0)
#endif

    for (int rep = 0; rep < ((DUP & 1) ? 2 : 1); ++rep)
    if (IN(0) && !NO_P0) {
        int z = 0; asm volatile("" : "+s"(z));
        unsigned char* ws = (unsigned char*)args.in[z + 17]; float* ssq = (float*)(ws + WS_SSQ); float* BT = (float*)(ws + WS_BT); bf16* XB = (bf16*)(ws + WS_XB);
        const int gw = vcu * NWAVES + wave, NGW = G * NWAVES;
        constexpr int I_IN = (D / 64) * (PW / 64), I_OUT = (D / 64) * (D / 64), I_UP = (D / 64) * (FF / 64), I_DN = (FF / 64) * (D / 64), I_L = I_IN + I_OUT + I_UP + I_DN;
        const float* const w_in = args.in[z + 1]; const float* const w_out = args.in[z + 2]; const float* const w_up = args.in[z + 13]; const float* const w_dn = args.in[z + 14];
        const float* const g_attn = args.in[z + 11]; const float* const g_mlp = args.in[z + 12];
        auto decode = [&](int it) -> TItem {
            const int l = it / I_L; int r = it % I_L; TItem d;
            const float* W; bf16* WT; const float* g = nullptr; int K = D, N = D, perm = 0;
            if (r < I_IN) { W = w_in + (size_t)l * D * PW; WT = (bf16*)(ws + WS_WIN) + (size_t)l * PW * D; N = PW; g = g_attn + l * D; perm = 1; }
            else if ((r -= I_IN) < I_OUT) { W = w_out + (size_t)l * D * D; WT = (bf16*)(ws + WS_WOUT) + (size_t)l * D * D; }
            else if ((r -= I_OUT) < I_UP) { W = w_up + (size_t)l * D * FF; WT = (bf16*)(ws + WS_WUP) + (size_t)l * FF * D; N = FF; g = g_mlp + l * D; }
            else { r -= I_UP; W = w_dn + (size_t)l * FF * D; WT = (bf16*)(ws + WS_WDN) + (size_t)l * D * FF; K = FF; }
            const int nblk = N / 64, k0 = 64 * (r / nblk), n0 = 64 * (r % nblk);
            d.src = W + (size_t)k0 * N + n0; d.g = g ? g + k0 : nullptr; d.dst = WT + (size_t)(k0 >> 6) * (256 * 64); d.N = N; d.K = K; d.perm = perm | (n0 << 1);
            return d; };
        {
            int it = gw; f32x4 va[16]; float ga[16]; TItem d0;
            if (it < DEPTH * I_L) { d0 = decode(it); titem_load(d0, va, ga, lane); }
            while (it < DEPTH * I_L) {
                const int itn = it + NGW; f32x4 vb[16]; float gb[16]; TItem d1;
                if (itn < DEPTH * I_L) { d1 = decode(itn); titem_load(d1, vb, gb, lane); }
                titem_process(d0, va, ga, lane);
                if (itn < DEPTH * I_L) {
#pragma unroll
                    for (int i = 0; i < 16; ++i) { va[i] = vb[i]; ga[i] = gb[i]; }
                    d0 = d1; }
                it = itn;
            }
        }
        const int gt = bx * (NWAVES * 64) + tid, NGT = G * NWAVES * 64;
        for (int i = gt; i < 16 * 384; i += NGT) { const int hm = i / 384, d = i % 384 - 128;
            BT[i] = d < 0 ? -1e30f : args.in[z + 15][t5_bucket(d > 127 ? 127 : d) * 16 + hm] * 1.4426950408889634f; }
        const float* x = args.in[z + 0];
        for (int row = gw; row < T; row += NGW) {
            const f32x4* xr = (const f32x4*)(x + (size_t)row * D) + lane; float s = 0.f;
            bf16* const xbrow = XB + (size_t)(row >> 8) * (D / 64) * (256 * 64);
#pragma unroll
            for (int j = 0; j < 8; ++j) { const f32x4 v = xr[64 * j]; s += (v[0] * v[0] + v[1] * v[1]) + (v[2] * v[2] + v[3] * v[3]);
                { const int col = 256 * j + 4 * lane; *(unsigned long long*)(xbrow + (size_t)(col >> 6) * (256 * 64) + pg8::blk_off(row & 255, col & 63)) = (unsigned long long)pk2(v[0], v[1]) | ((unsigned long long)pk2(v[2], v[3]) << 32); } }
            s = wave_sum(s); if (lane < 32) ssq[(size_t)row * 32 + lane] = (lane == 0) ? s : 0.f;
        }
        SEAM(0);
    }

    for (int l = 0; l < DEPTH; ++l) {
        const int p0 = 1 + 5 * l;
        for (int rep = 0; rep < ((DUP & 2) ? 2 : 1); ++rep)
        if (IN(p0) && !NO_PROJ) {
            int ll = l, z = 0; asm volatile("" : "+s"(ll), "+s"(z));
            unsigned char* w = (unsigned char*)args.in[z + 17]; float* xout = (float*)args.in[z + 16];
            pg8::Gemm g{(const bf16*)(w + WS_XB), (const bf16*)(w + WS_WIN) + (size_t)ll * PW * D, T, PW, D, 1  }; pg8::StaticOrder S; S.init(T, PW, G, bx);
            pg8::EpiProj E{(bf16*)(w + WS_PROJ), (const float*)(w + WS_SSQ) + (size_t)(2 * ll) * T * 32, args.in[z + 4] + ll * 64, args.in[z + 5] + ll * 64, PW};
            pg8::gemm_phase<pg8::EpiProj, pg8::StaticOrder, true, true>((LAS unsigned char*)lds, g, S, E);
            SEAM(p0);
        }
        for (int rep = 0; rep < ((DUP & 4) ? 2 : 1); ++rep)
        if (IN(p0 + 1) && !NO_ATT) {
            int ll = l, z = 0; asm volatile("" : "+s"(ll), "+s"(z));
            unsigned char* w = (unsigned char*)args.in[z + 17]; float* xout = (float*)args.in[z + 16];
            const bf16* PROJ = (const bf16*)(w + WS_PROJ); bf16* MIX = (bf16*)(w + WS_MIX); const float* BT = (const float*)(w + WS_BT);
            const float lam_init = 0.8f - 0.6f * expf(-0.3f * (float)ll);
            float a = args.in[z + 6][ll * 64 + lane] * args.in[z + 7][ll * 64 + lane], b2 = args.in[z + 8][ll * 64 + lane] * args.in[z + 9][ll * 64 + lane];
            a = wave_sum(a); b2 = wave_sum(b2);
            const float lam = expf(a) - expf(b2) + lam_init;
            float gqm = fabsf(args.in[z + 4][ll * 64 + lane]), gkm = fabsf(args.in[z + 5][ll * 64 + lane]);
#pragma unroll
            for (int o = 1; o < 64; o <<= 1) { gqm = fmaxf(gqm, __shfl_xor(gqm, o)); gkm = fmaxf(gkm, __shfl_xor(gkm, o)); }
            const float gqk = gqm * gkm;
            for (int pr = vcu; pr < BATCH * NH * 8 && !NO_ATTU; pr += G) {
                const int bh = pr >> 3, s = pr & 7;
#pragma unroll 1
                for (int half = 0; half < 2; ++half)
                {   const int qb = half == 0 ? 15 - s : s, hh = bh % NH;
                    float bm = fmaxf(fmaxf(BT[hh * 768 + 128 + lane], BT[hh * 768 + 128 + 64 + lane]), fmaxf(BT[hh * 768 + 384 + 128 + lane], BT[hh * 768 + 384 + 128 + 64 + lane]));
#pragma unroll
                    for (int o = 1; o < 64; o <<= 1) bm = fmaxf(bm, __shfl_xor(bm, o));
                    const float sref = 11.8f * gqk + bm + 0.25f;
                    if (sref <= 40.f) att::attn_unit<true>(bh / NH, hh, qb, (const att::bf16*)PROJ, (att::bf16*)MIX, BT, args.in[z + 10] + ll * 128, lam, 1.0f - lam_init, sref, args.in[z + 3] + (size_t)ll * 3 * CONVW, pr * 8 + half * 4, (char*)lds);
                    else att::attn_unit<false>(bh / NH, hh, qb, (const att::bf16*)PROJ, (att::bf16*)MIX, BT, args.in[z + 10] + ll * 128, lam, 1.0f - lam_init, 0.f, args.in[z + 3] + (size_t)ll * 3 * CONVW, pr * 8 + half * 4, (char*)lds);
                }
            }
            SEAM(p0 + 1);
        }
        if (IN(p0 + 2) && !NO_OUT) {
            int ll = l, z = 0; asm volatile("" : "+s"(ll), "+s"(z));
            unsigned char* w = (unsigned char*)args.in[z + 17]; float* xout = (float*)args.in[z + 16];
            pg8::Gemm g{(const bf16*)(w + WS_MIX), (const bf16*)(w + WS_WOUT) + (size_t)ll * D * D, T, D, D, 0}; pg8::StaticOrder S; S.init(T, D, G, bx);
            pg8::EpiResid E{(ll == 0) ? args.in[z + 0] : (const float*)nullptr, (float*)nullptr, (bf16*)(w + WS_XB), (float*)(w + WS_SSQ) + (size_t)(2 * ll + 1) * T * 32, D};
            pg8::gemm_phase<pg8::EpiResid, pg8::StaticOrder, false, true>((LAS unsigned char*)lds, g, S, E);
            SEAM(p0 + 2);
        }
        for (int rep = 0; rep < ((DUP & 8) ? 2 : 1); ++rep)
        if (IN(p0 + 3) && !NO_UP) {
            int ll = l, z = 0; asm volatile("" : "+s"(ll), "+s"(z));
            unsigned char* w = (unsigned char*)args.in[z + 17]; float* xout = (float*)args.in[z + 16];
            pg8::Gemm g{(const bf16*)(w + WS_XB), (const bf16*)(w + WS_WUP) + (size_t)ll * FF * D, T, FF, D, 1  }; pg8::StaticOrder S; S.init(T, FF, G, bx);
            pg8::EpiUp E{(bf16*)(w + WS_U), (const float*)(w + WS_SSQ) + (size_t)(2 * ll + 1) * T * 32, FF};
            pg8::gemm_phase<pg8::EpiUp, pg8::StaticOrder, true, true>((LAS unsigned char*)lds, g, S, E);
            SEAM(p0 + 3);
        }
        if (IN(p0 + 4) && !NO_DN) {
            int ll = l, z = 0; asm volatile("" : "+s"(ll), "+s"(z));
            unsigned char* w = (unsigned char*)args.in[z + 17]; float* xout = (float*)args.in[z + 16];
            pg8::Gemm g{(const bf16*)(w + WS_U), (const bf16*)(w + WS_WDN) + (size_t)ll * D * FF, T, D, FF, 1  }; pg8::StaticOrder S; S.init(T, D, G, bx);
            pg8::EpiResid E{(const float*)nullptr, (ll == DEPTH - 1) ? xout : (float*)nullptr, (bf16*)(w + WS_XB), (float*)(w + WS_SSQ) + (size_t)(2 * ll + 2) * T * 32, D};
            pg8::gemm_phase<pg8::EpiResid, pg8::StaticOrder, false, true>((LAS unsigned char*)lds, g, S, E);
            SEAM(p0 + 4);
        }
    }
#undef IN
#undef SEAM
}

extern "C" void kernel_launch(void* const* d_in, const int* in_sizes, int n_in, void* d_out, int out_size, void* d_ws, size_t ws_size, hipStream_t stream) {
    static int grid = 0;
    if (grid == 0) {
        if (n_in != 16 || in_sizes[0] != T * D || out_size != T * D || ws_size < WS_END) { fprintf(stderr, "kernel_launch: unexpected shapes (n_in %d in0 %d out %d ws %zu); nothing launched\n", n_in, n_in > 0 ? in_sizes[0] : -1, out_size, ws_size); grid = -1; return; }
        int dev = 0, cus = 0, per_cu = 0;
        if (hipGetDevice(&dev) != hipSuccess || hipDeviceGetAttribute(&cus, hipDeviceAttributeMultiprocessorCount, dev) != hipSuccess) { fprintf(stderr, "kernel_launch: device query failed\n"); grid = -1; return; }
        if (hipFuncSetAttribute((const void*)hybrid_fwd, hipFuncAttributeMaxDynamicSharedMemorySize, LDS_BYTES) != hipSuccess) { fprintf(stderr, "kernel_launch: hipFuncSetAttribute failed\n"); grid = -1; return; }
        if (hipOccupancyMaxActiveBlocksPerMultiprocessor(&per_cu, (const void*)hybrid_fwd, NWAVES * 64, LDS_BYTES) != hipSuccess || per_cu < 1) { fprintf(stderr, "kernel_launch: occupancy query says %d blocks per CU\n", per_cu); per_cu = 1; }
        (void)hipGetLastError();
        grid = cus * per_cu;
        fprintf(stderr, "kernel_launch: grid %d (%d CUs x %d)\n", grid, cus, per_cu);
    }
    if (grid < 0) return;
    if (hipMemsetAsync((char*)d_ws + WS_CTL, 0, CTL_ZERO_BYTES, stream) != hipSuccess) { fprintf(stderr, "kernel_launch: hipMemsetAsync failed\n"); return; }
    Args a{};
    for (int i = 0; i < 16; ++i) a.in[i] = (const float*)d_in[i];
    a.in[16] = (const float*)d_out; a.in[17] = (const float*)d_ws;
#if MK_PER_PHASE
    for (int ph = 0; ph < N_PHASES; ++ph) { a.ph_lo = ph; a.ph_hi = ph + 1; hipLaunchKernelGGL(hybrid_fwd, dim3(grid), dim3(NWAVES * 64), LDS_BYTES, stream, a); }
#else
    a.ph_lo = 0; a.ph_hi = N_PHASES;
    void* kargs[] = {&a};
    const hipError_t e = hipLaunchCooperativeKernel((const void*)hybrid_fwd, dim3(grid), dim3(NWAVES * 64), kargs, LDS_BYTES, stream);
    if (e != hipSuccess) fprintf(stderr, "kernel_launch: cooperative launch failed: %s (grid %d)\n", hipGetErrorString(e), grid);
#endif
    const hipError_t le = hipPeekAtLastError();
    if (le != hipSuccess) fprintf(stderr, "kernel_launch: launch error %s\n", hipGetErrorName(le));
}
```

```cpp
#include <hip/hip_runtime.h>
#include <hip/hip_bf16.h>
#include <hip/hip_cooperative_groups.h>
#include <cstdio>
#include <cstdint>
#include <cmath>
namespace cg = cooperative_groups;
namespace pg8 {
#define PG8_LAS __attribute__((address_space(3)))
typedef unsigned short bf16_t;
typedef short bf16x8 __attribute__((ext_vector_type(8)));
typedef float f32x4 __attribute__((ext_vector_type(4)));
typedef unsigned u32x4 __attribute__((ext_vector_type(4)));
constexpr int BM = 256, BK = 64, HALF = 128, HTB = HALF * BK * 2  , STAGE_BYTES = 8 * HTB, NXCD = 8, WGM = 4;

__host__ __device__ __forceinline__ int lds_byte(int r, int c) { const int st = (r >> 4) * 2 + (c >> 5), rr = r & 15, cc = c & 31, ob = rr * 64 + cc * 2; return st * 1024 + (ob ^ (((ob >> 9) & 1) << 5)); }
__host__ __device__ __forceinline__ void stage_rc(int b, int& R, int& C) { const int st = b / 1024, sb = b % 1024, swz = sb ^ (((sb >> 9) & 1) << 5); R = (st >> 1) * 16 + swz / 64; C = (st & 1) * 32 + (swz % 64) / 2; }
__host__ __device__ __forceinline__ int perm32(int rho) { const int n = rho >> 4, i = rho & 15; return 8 * (i >> 2) + 4 * n + (i & 3); }

__host__ __device__ __forceinline__ int blk_off(int r, int c) { const int rr = r & 127; return (r >> 7) * 8192 + (((rr >> 4) * 2 + (c >> 5)) * 512) + (rr & 15) * 32 + (c & 31); }
struct Unit { int pm, pn; };
struct Gemm { const bf16_t* A; const bf16_t* Bt; int M, N, K; int a_blocked; };

struct StaticOrder {
    int nM, nN, nwg, G, c;
    __host__ __device__ void init(int M, int N, int G_, int c_) { nM = M / BM; nN = N / BM; nwg = nM * nN; G = G_; c = c_; }
    __host__ __device__ bool next(int i, Unit& u) const {
        const long L = (long)i * G + c; if (L >= nwg) return false;
        int wgid = (int)L; { const int q = nwg / NXCD, r = nwg % NXCD, xcd = wgid % NXCD, off = wgid / NXCD; wgid = (xcd < r ? xcd * (q + 1) : r * (q + 1) + (xcd - r) * q) + off; }
        const int nig = WGM * nN, gid = wgid / nig, fm = gid * WGM, gsz = (nM - fm) < WGM ? (nM - fm) : WGM;
        u.pm = fm + ((wgid % nig) % gsz); u.pn = (wgid % nig) / gsz; return true;
    }
    __device__ __forceinline__ void a_ready(const Unit&) const {}
    __device__ __forceinline__ void done(const Unit&) const {}
};

__device__ __forceinline__ unsigned cvt_pk_bf16(float lo, float hi) { unsigned r; asm volatile("v_cvt_pk_bf16_f32 %0, %1, %2" : "=v"(r) : "v"(lo), "v"(hi)); return r; }
typedef float f32x2 __attribute__((ext_vector_type(2)));
constexpr float RMS_EPS = 1e-6f;
constexpr float QC2 = 0.125f * 1.4426950408889634f;
typedef unsigned u32x2e __attribute__((ext_vector_type(2)));
__device__ __forceinline__ float row_rstd(const float* ssq, int row) {
    const f32x4* p = (const f32x4*)(ssq + (size_t)row * 32); f32x4 a = p[0];
#pragma unroll
    for (int i = 1; i < 8; ++i) a = a + p[i];
    return 1.0f / sqrtf(((a[0] + a[1]) + (a[2] + a[3])) * (1.0f / 2048.0f) + RMS_EPS);
}
__device__ __forceinline__ void zero_acc(f32x4 (&acc)[2][2][4][2]) {
#pragma unroll
    for (int a = 0; a < 2; ++a)
#pragma unroll
        for (int b = 0; b < 2; ++b)
#pragma unroll
            for (int m = 0; m < 4; ++m)
#pragma unroll
                for (int n = 0; n < 2; ++n) acc[a][b][m][n] = (f32x4){0.f, 0.f, 0.f, 0.f};
}
__device__ __forceinline__ void rows_rstd(float (&rs)[2][4], const float* ssq, int row0, int fq) {
    f32x4 pa[2][4], pb[2][4];
#pragma unroll
    for (int ai = 0; ai < 2; ++ai)
#pragma unroll
        for (int m = 0; m < 4; ++m) { const f32x4* p = (const f32x4*)(ssq + (size_t)(row0 + ai * HALF + m * 16) * 32 + 8 * fq); pa[ai][m] = p[0]; pb[ai][m] = p[1]; }
#pragma unroll
    for (int ai = 0; ai < 2; ++ai)
#pragma unroll
        for (int m = 0; m < 4; ++m) { const f32x4 a = pa[ai][m] + pb[ai][m]; float t = (a[0] + a[1]) + (a[2] + a[3]);
            t += __shfl_xor(t, 16); t += __shfl_xor(t, 32); rs[ai][m] = 1.0f / sqrtf(t * (1.0f / 2048.0f) + RMS_EPS); }
}
struct RsState { f32x4 ra, rb; int pm; };
struct NoState { int pm; };
struct EpiProj {
    typedef RsState State; static constexpr int KR = 1;
    static constexpr bool PERM = true, AFTER_DRAIN = false;
    bf16_t* O; const float* ssq; const float* qg; const float* kg; int ldc;
    __device__ __forceinline__ void init(f32x4 (&acc)[2][2][4][2], State& st, const Unit& u, int wr, int, int fr, int fq) const { zero_acc(acc);
        if (st.pm != u.pm) { float t[2][4]; rows_rstd(t, ssq, u.pm * BM + wr * 64 + fr, fq); st.ra = (f32x4){t[0][0], t[0][1], t[0][2], t[0][3]}; st.rb = (f32x4){t[1][0], t[1][1], t[1][2], t[1][3]}; st.pm = u.pm; } }
    __device__ __forceinline__ void operator()(const f32x4 (&acc)[2][2][4][2], const State& st, const Unit& u, int wr, int wc, int fr, int fq) const {
        const int row0 = u.pm * BM + wr * 64 + fr, col0 = u.pn * BM + wc * 64 + 8 * fq;
        const float rsv[2][4] = {{st.ra[0], st.ra[1], st.ra[2], st.ra[3]}, {st.rb[0], st.rb[1], st.rb[2], st.rb[3]}};
        const bool qk = u.pn < 8, isq = u.pn < 4;
        f32x4 g[2][2];
#pragma unroll
        for (int bj = 0; bj < 2; ++bj)
#pragma unroll
            for (int n = 0; n < 2; ++n) { g[bj][n] = (f32x4){1.f, 1.f, 1.f, 1.f};
                if (qk) { g[bj][n] = *(const f32x4*)((isq ? qg : kg) + 32 * bj + 8 * fq + 4 * n); if (isq) g[bj][n] = g[bj][n] * QC2; } }
#pragma unroll
        for (int ai = 0; ai < 2; ++ai)
#pragma unroll
            for (int m = 0; m < 4; ++m) { const int row = row0 + ai * HALF + m * 16;
                const float rs = rsv[ai][m];
                f32x4 v[2][2];
#pragma unroll
                for (int bj = 0; bj < 2; ++bj)
#pragma unroll
                    for (int n = 0; n < 2; ++n) v[bj][n] = acc[ai][bj][m][n] * rs;
                if (qk) { float s = 0.f;
#pragma unroll
                    for (int bj = 0; bj < 2; ++bj)
#pragma unroll
                        for (int n = 0; n < 2; ++n) { const f32x4 x = v[bj][n]; s += (x[0] * x[0] + x[1] * x[1]) + (x[2] * x[2] + x[3] * x[3]); }
                    s += __shfl_xor(s, 16); s += __shfl_xor(s, 32);
                    const float r = 1.0f / sqrtf(s * (1.0f / 64.0f) + RMS_EPS);
#pragma unroll
                    for (int bj = 0; bj < 2; ++bj)
#pragma unroll
                        for (int n = 0; n < 2; ++n) v[bj][n] = v[bj][n] * r * g[bj][n]; }
                if (u.pn >= 16) {
                    const f32x4 q0 = v[0][0] * v[1][0], q1 = v[0][1] * v[1][1];
                    u32x4 w; w.x = cvt_pk_bf16(q0[0], q0[1]); w.y = cvt_pk_bf16(q0[2], q0[3]); w.z = cvt_pk_bf16(q1[0], q1[1]); w.w = cvt_pk_bf16(q1[2], q1[3]);
                    *(u32x4*)(O + (size_t)row * ldc + 4096 + (u.pn - 16) * 128 + wc * 32 + 8 * fq) = w;
                } else {
                bf16_t* rowp = O + (size_t)row * ldc + col0;
#pragma unroll
                for (int bj = 0; bj < 2; ++bj) { u32x4 w; w.x = cvt_pk_bf16(v[bj][0][0], v[bj][0][1]); w.y = cvt_pk_bf16(v[bj][0][2], v[bj][0][3]); w.z = cvt_pk_bf16(v[bj][1][0], v[bj][1][1]); w.w = cvt_pk_bf16(v[bj][1][2], v[bj][1][3]);
                    *(u32x4*)(rowp + 32 * bj) = w; } } }
    }
};
struct EpiUp {
    typedef RsState State; static constexpr int KR = 1;
    static constexpr bool PERM = true, AFTER_DRAIN = false;
    bf16_t* O; const float* ssq; int ldc;
    __device__ __forceinline__ void init(f32x4 (&acc)[2][2][4][2], State& st, const Unit& u, int wr, int, int fr, int fq) const { zero_acc(acc);
        if (st.pm != u.pm) { float t[2][4]; rows_rstd(t, ssq, u.pm * BM + wr * 64 + fr, fq); st.ra = (f32x4){t[0][0], t[0][1], t[0][2], t[0][3]}; st.rb = (f32x4){t[1][0], t[1][1], t[1][2], t[1][3]}; st.pm = u.pm; } }
    __device__ __forceinline__ void operator()(const f32x4 (&acc)[2][2][4][2], const State& st, const Unit& u, int wr, int wc, int fr, int fq) const {
        const int row0 = u.pm * BM + wr * 64 + fr, col0 = u.pn * BM + wc * 32 + 8 * fq;
        const float rsv[2][4] = {{st.ra[0], st.ra[1], st.ra[2], st.ra[3]}, {st.rb[0], st.rb[1], st.rb[2], st.rb[3]}};
#pragma unroll
        for (int ai = 0; ai < 2; ++ai)
#pragma unroll
            for (int m = 0; m < 4; ++m) { const int row = row0 + ai * HALF + m * 16;
                const float rs = rsv[ai][m];
                bf16_t* rowp = O + (size_t)(row >> 8) * (ldc >> 6) * (256 * 64);
#pragma unroll
                for (int bj = 0; bj < 2; ++bj) { f32x4 v0 = acc[ai][bj][m][0] * rs, v1 = acc[ai][bj][m][1] * rs;
#pragma unroll
                    for (int e = 0; e < 4; ++e) { const float a = fmaxf(v0[e], 0.f), b = fmaxf(v1[e], 0.f); v0[e] = a * a; v1[e] = b * b; }
                    u32x4 w; w.x = cvt_pk_bf16(v0[0], v0[1]); w.y = cvt_pk_bf16(v0[2], v0[3]); w.z = cvt_pk_bf16(v1[0], v1[1]); w.w = cvt_pk_bf16(v1[2], v1[3]);
                    { const int col = col0 + bj * HALF; *(u32x4*)(rowp + (size_t)(col >> 6) * (256 * 64) + blk_off(row & 255, col & 63)) = w; } } }
    }
};
struct EpiResid {
    typedef NoState State; static constexpr int KR = 1;
    static constexpr bool PERM = true, AFTER_DRAIN = false;
    const float* xin_f; float* xout_f; bf16_t* xb; float* ssq; int ldc;
    __device__ __forceinline__ size_t xb_off(int row, int col) const { return ((size_t)(row >> 8) * (ldc >> 6) + (col >> 6)) * (256 * 64) + blk_off(row & 255, col & 63); }
    __device__ __forceinline__ void init(f32x4 (&acc)[2][2][4][2], State&, const Unit& u, int wr, int wc, int fr, int fq) const {
        const int row0 = u.pm * BM + wr * 64 + fr, col0 = u.pn * BM + wc * 32 + 8 * fq;
        if (xin_f) {
#pragma unroll
            for (int ai = 0; ai < 2; ++ai)
#pragma unroll
                for (int m = 0; m < 4; ++m) { const size_t off = (size_t)(row0 + ai * HALF + m * 16) * ldc + col0;
#pragma unroll
                    for (int bj = 0; bj < 2; ++bj)
#pragma unroll
                        for (int n = 0; n < 2; ++n) acc[ai][bj][m][n] = *(const f32x4*)(xin_f + off + bj * HALF + n * 4); }
        } else {
#pragma unroll
            for (int ai = 0; ai < 2; ++ai)
#pragma unroll
                for (int m = 0; m < 4; ++m) { const size_t off = (size_t)(row0 + ai * HALF + m * 16) * ldc + col0;
#pragma unroll
                    for (int bj = 0; bj < 2; ++bj) { const u32x4 w = *(const u32x4*)(xb + xb_off(row0 + ai * HALF + m * 16, col0 + bj * HALF));
                        acc[ai][bj][m][0] = (f32x4){__uint_as_float(w.x << 16), __uint_as_float(w.x & 0xffff0000u), __uint_as_float(w.y << 16), __uint_as_float(w.y & 0xffff0000u)};
                        acc[ai][bj][m][1] = (f32x4){__uint_as_float(w.z << 16), __uint_as_float(w.z & 0xffff0000u), __uint_as_float(w.w << 16), __uint_as_float(w.w & 0xffff0000u)}; } }
        }
    }
    __device__ __forceinline__ void operator()(const f32x4 (&acc)[2][2][4][2], const State&, const Unit& u, int wr, int wc, int fr, int fq) const {
        const int row0 = u.pm * BM + wr * 64 + fr, col0 = u.pn * BM + wc * 32 + 8 * fq;
        if (xout_f) {
#pragma unroll
            for (int ai = 0; ai < 2; ++ai)
#pragma unroll
                for (int m = 0; m < 4; ++m) { const size_t off = (size_t)(row0 + ai * HALF + m * 16) * ldc + col0;
#pragma unroll
                    for (int bj = 0; bj < 2; ++bj)
#pragma unroll
                        for (int n = 0; n < 2; ++n) *(f32x4*)(xout_f + off + bj * HALF + n * 4) = acc[ai][bj][m][n]; }
        } else {
#pragma unroll
            for (int ai = 0; ai < 2; ++ai)
#pragma unroll
                for (int m = 0; m < 4; ++m) { const int row = row0 + ai * HALF + m * 16; const size_t off = (size_t)row * ldc + col0; float ss = 0.f;
#pragma unroll
                    for (int bj = 0; bj < 2; ++bj) { const f32x4 v0 = acc[ai][bj][m][0], v1 = acc[ai][bj][m][1];
                        u32x4 w; w.x = cvt_pk_bf16(v0[0], v0[1]); w.y = cvt_pk_bf16(v0[2], v0[3]); w.z = cvt_pk_bf16(v1[0], v1[1]); w.w = cvt_pk_bf16(v1[2], v1[3]);
                        *(u32x4*)(xb + xb_off(row, col0 + bj * HALF)) = w;
                        ss += ((v0[0] * v0[0] + v0[1] * v0[1]) + (v0[2] * v0[2] + v0[3] * v0[3])) + ((v1[0] * v1[0] + v1[1] * v1[1]) + (v1[2] * v1[2] + v1[3] * v1[3])); }
                    ss += __shfl_xor(ss, 16); ss += __shfl_xor(ss, 32);
                    if (fq == 0) ssq[(size_t)row * 32 + u.pn * 4 + wc] = ss; }
        }
    }
};
#ifndef KREP
#define KREP 1
#endif
template <class Epi, class Sched, bool ALIGN_EPI = false, bool SP2 = false>
__device__ __forceinline__ void gemm_phase(PG8_LAS unsigned char* lds, const Gemm g, const Sched& S, const Epi& E) {
    int tid_ = threadIdx.x; asm volatile("" : "+v"(tid_));
    const int tid = tid_, wid = __builtin_amdgcn_readfirstlane(tid >> 6), lane = tid & 63, wr = wid >> 2, wc = wid & 3, fr = lane & 15, fq = lane >> 4;
    const int K = g.K, nt = K / BK;
    constexpr int KR = (KREP == 2) ? 2 : Epi::KR;
    const int Ka = g.a_blocked ? BK : g.K;
    unsigned voffA[2], voffB[2];
#pragma unroll
    for (int i = 0; i < 2; ++i) { int R, C; stage_rc(tid * 16 + i * 8192, R, C); const int Rb = Epi::PERM ? ((R & ~31) + perm32(R & 31)) : R;
        voffA[i] = g.a_blocked ? (unsigned)blk_off(R, C) * 2u : (unsigned)(R * Ka + C) * 2u; static_assert(Epi::PERM, "the weight copies are stored with the PERM row order baked in"); (void)Rb; voffB[i] = (unsigned)blk_off(R, C) * 2u; }
    const size_t kstep = (size_t)(BK * 2);
    const size_t hstep = (size_t)HALF * K * 2;
    const size_t kstepB = (size_t)(BM * BK * 2), hstepB = (size_t)(HALF * BK * 2);
    const size_t kstepA = g.a_blocked ? (size_t)(BM * BK * 2) : kstep, hstepA = g.a_blocked ? (size_t)(HALF * BK * 2) : hstep;
    const size_t tstep = 2 * hstep;
    const unsigned ldsw = (unsigned)wid * 1024u;
    const int aoff = lds_byte(wr * 64 + fr, fq * 8), boff = lds_byte(wc * 32 + fr, fq * 8);
#define PG8_SA(b, h) (((b) * 2 + (h)) * HTB)
#define PG8_SB(b, h) ((4 + (b) * 2 + (h)) * HTB)
#define PG8_STAGE(bufoff, gbase, voff) do { _Pragma("unroll") for (int _i = 0; _i < 2; ++_i) \
        __builtin_amdgcn_global_load_lds((const unsigned*)((const char*)(gbase) + (voff)[_i]), (PG8_LAS unsigned*)(lds + (bufoff) + ldsw + _i * 8192), 16, 0, 0); } while (0)
#define PG8_LDA(dst, b, h) do { _Pragma("unroll") for (int m = 0; m < 4; ++m) _Pragma("unroll") for (int k = 0; k < 2; ++k) dst[m][k] = *(const PG8_LAS bf16x8*)(lds + PG8_SA(b, h) + aoff + m * 2048 + k * 1024); } while (0)
#define PG8_LDB(dst, b, h) do { _Pragma("unroll") for (int n = 0; n < 2; ++n) _Pragma("unroll") for (int k = 0; k < 2; ++k) dst[n][k] = *(const PG8_LAS bf16x8*)(lds + PG8_SB(b, h) + boff + n * 2048 + k * 1024); } while (0)
#define PG8_MMA(ai, bj, At, Bt) do { __builtin_amdgcn_s_setprio(1); _Pragma("unroll") for (int m = 0; m < 4; ++m) _Pragma("unroll") for (int n = 0; n < 2; ++n) _Pragma("unroll") for (int k = 0; k < 2; ++k) \
        acc[ai][bj][m][n] = __builtin_amdgcn_mfma_f32_16x16x32_bf16(Bt[n][k], At[m][k], acc[ai][bj][m][n], 0, 0, 0); __builtin_amdgcn_s_setprio(0); } while (0)
#define PG8_WAIT_V(n) asm volatile("s_waitcnt vmcnt(" #n ")" ::: "memory")
#define PG8_WAIT_L(n) asm volatile("s_waitcnt lgkmcnt(" #n ")" ::: "memory")
#define PG8_BAR __builtin_amdgcn_s_barrier()
#define PG8_SCHED __builtin_amdgcn_sched_barrier(0)
    Unit cur, nxt; int ui = 0;
    if (!S.next(0, cur)) return;
    f32x4 acc[2][2][4][2];
    typename Epi::State est; est.pm = -1;
    E.init(acc, est, cur, wr, wc, fr, fq);
    bf16x8 At[4][2], B0[2][2], B1[2][2];
    const char* cA = (const char*)g.A + (size_t)cur.pm * tstep; const char* cB = (const char*)g.Bt + (size_t)cur.pn * tstep;
    S.a_ready(cur);
    if constexpr (SP2) {
        PG8_STAGE(PG8_SB(0, 0), cB, voffB); PG8_STAGE(PG8_SB(0, 1), cB + hstepB, voffB); PG8_STAGE(PG8_SA(0, 0), cA, voffA); PG8_STAGE(PG8_SA(0, 1), cA + hstepA, voffA);
        if (wr == 1) PG8_BAR;
        PG8_WAIT_V(2); PG8_BAR;
        PG8_STAGE(PG8_SB(1, 0), cB + kstepB, voffB); PG8_STAGE(PG8_SA(1, 0), cA + kstepA, voffA); PG8_STAGE(PG8_SB(1, 1), cB + hstepB + kstepB, voffB);
        PG8_WAIT_V(6); PG8_BAR;
    } else {
        PG8_STAGE(PG8_SB(0, 0), cB, voffB); PG8_STAGE(PG8_SA(0, 0), cA, voffA); PG8_STAGE(PG8_SB(0, 1), cB + hstepB, voffB); PG8_STAGE(PG8_SA(0, 1), cA + hstepA, voffA);
        if (wr == 1) PG8_BAR;
        PG8_WAIT_V(4); PG8_BAR;
        PG8_STAGE(PG8_SB(1, 0), cB + kstepB, voffB); PG8_STAGE(PG8_SA(1, 0), cA + kstepA, voffA); PG8_STAGE(PG8_SB(1, 1), cB + hstepB + kstepB, voffB);
        PG8_WAIT_V(6); PG8_BAR;
    }
    for (;;) {
        const bool has_next = S.next(ui + 1, nxt);
        const char* nA = has_next ? (const char*)g.A + (size_t)nxt.pm * tstep : cA; const char* nB = has_next ? (const char*)g.Bt + (size_t)nxt.pn * tstep : cB;
        for (int t0_ = 0; t0_ < KR * nt; t0_ += 2) {
            const bool last = (t0_ == KR * nt - 2); const int t = (KR == 1) ? t0_ : (t0_ % nt), t2_ = (KR == 1) ? t0_ + 2 : ((t0_ + 2) % nt);
            const char* a1 = cA + (size_t)(t + 1) * kstepA;
            const char* a2 = last ? nA : cA + (size_t)t2_ * kstepA; const char* b2 = last ? nB : cB + (size_t)t2_ * kstepB;
            const char* a3 = a2 + kstepA; const char* b3 = b2 + kstepB;
            if (last && has_next) S.a_ready(nxt);
            if constexpr (SP2) {
            PG8_LDB(B0, 0, 0); PG8_LDB(B1, 0, 1); PG8_SCHED; PG8_LDA(At, 0, 0); PG8_STAGE(PG8_SA(1, 1), a1 + hstepA, voffA);
            PG8_WAIT_V(8); PG8_WAIT_L(0); PG8_BAR; PG8_MMA(0, 0, At, B0); PG8_MMA(0, 1, At, B1); PG8_BAR; PG8_SCHED;
            PG8_LDA(At, 0, 1); PG8_STAGE(PG8_SB(0, 0), b2, voffB); PG8_STAGE(PG8_SB(0, 1), b2 + hstepB, voffB); PG8_STAGE(PG8_SA(0, 0), a2, voffA);
            PG8_WAIT_V(8); PG8_WAIT_L(0); PG8_BAR; PG8_MMA(1, 0, At, B0); PG8_MMA(1, 1, At, B1); PG8_BAR; PG8_SCHED;
            PG8_LDB(B0, 1, 0); PG8_LDB(B1, 1, 1); PG8_SCHED; PG8_LDA(At, 1, 0); PG8_STAGE(PG8_SA(0, 1), a2 + hstepA, voffA);
            PG8_WAIT_V(8); PG8_WAIT_L(0); PG8_BAR; PG8_MMA(0, 0, At, B0); PG8_MMA(0, 1, At, B1); PG8_BAR; PG8_SCHED;
            PG8_LDA(At, 1, 1); PG8_STAGE(PG8_SB(1, 0), b3, voffB); PG8_STAGE(PG8_SB(1, 1), b3 + hstepB, voffB); PG8_STAGE(PG8_SA(1, 0), a3, voffA);
            PG8_WAIT_V(8); PG8_WAIT_L(0); PG8_BAR; PG8_MMA(1, 0, At, B0); PG8_MMA(1, 1, At, B1); PG8_BAR; PG8_SCHED;
            } else {
            PG8_LDB(B0, 0, 0); PG8_SCHED; PG8_LDA(At, 0, 0); PG8_STAGE(PG8_SA(1, 1), a1 + hstepA, voffA);
            PG8_WAIT_L(8); PG8_BAR; PG8_WAIT_L(0); PG8_MMA(0, 0, At, B0); PG8_BAR; PG8_SCHED;
            PG8_LDB(B1, 0, 1); PG8_STAGE(PG8_SB(0, 0), b2, voffB);
            PG8_BAR; PG8_WAIT_L(0); PG8_MMA(0, 1, At, B1); PG8_BAR;
            PG8_LDA(At, 0, 1); PG8_STAGE(PG8_SA(0, 0), a2, voffA);
            PG8_BAR; PG8_WAIT_L(0); PG8_MMA(1, 0, At, B0); PG8_BAR; PG8_SCHED;
            PG8_STAGE(PG8_SB(0, 1), b2 + hstepB, voffB);
            PG8_WAIT_V(6); PG8_BAR; PG8_MMA(1, 1, At, B1); PG8_BAR;
            PG8_LDB(B0, 1, 0); PG8_SCHED; PG8_LDA(At, 1, 0); PG8_STAGE(PG8_SA(0, 1), a2 + hstepA, voffA);
            PG8_WAIT_L(8); PG8_BAR; PG8_WAIT_L(0); PG8_MMA(0, 0, At, B0); PG8_BAR; PG8_SCHED;
            PG8_LDB(B1, 1, 1); PG8_STAGE(PG8_SB(1, 0), b3, voffB);
            PG8_BAR; PG8_WAIT_L(0); PG8_MMA(0, 1, At, B1); PG8_BAR;
            PG8_LDA(At, 1, 1); PG8_STAGE(PG8_SA(1, 0), a3, voffA);
            PG8_BAR; PG8_WAIT_L(0); PG8_MMA(1, 0, At, B0); PG8_BAR; PG8_SCHED;
            PG8_STAGE(PG8_SB(1, 1), b3 + hstepB, voffB);
            PG8_WAIT_V(6); PG8_BAR; PG8_MMA(1, 1, At, B1); PG8_BAR;
            }
        }
        if constexpr (KR == 2) {
#pragma unroll
            for (int a = 0; a < 2; ++a)
#pragma unroll
                for (int b = 0; b < 2; ++b)
#pragma unroll
                    for (int m = 0; m < 4; ++m)
#pragma unroll
                        for (int n = 0; n < 2; ++n) acc[a][b][m][n] = acc[a][b][m][n] * 0.5f;
        }
        if constexpr (ALIGN_EPI) { if (wr == 0) PG8_BAR; }
        if constexpr (!Epi::AFTER_DRAIN) { E(acc, est, cur, wr, wc, fr, fq); S.done(cur); }
        if (!has_next) break;
        E.init(acc, est, nxt, wr, wc, fr, fq);
        cur = nxt; cA = nA; cB = nB; ++ui;
        if constexpr (ALIGN_EPI) { if (wr == 1) PG8_BAR; }
    }
    PG8_WAIT_V(0);
    if constexpr (!ALIGN_EPI) { if (wr == 0) PG8_BAR; }
    PG8_BAR;
    if constexpr (Epi::AFTER_DRAIN) { E.fused(acc, cur, wr, wc, fr, fq, lds, wid, lane); S.done(cur); }
#undef PG8_SA
#undef PG8_SB
#undef PG8_STAGE
#undef PG8_LDA
#undef PG8_LDB
#undef PG8_MMA
#undef PG8_WAIT_V
#undef PG8_WAIT_L
#undef PG8_BAR
#undef PG8_SCHED
}
}
namespace att {
using bf16 = __hip_bfloat16;
using bf16x8 = __attribute__((ext_vector_type(8))) short;
using s16x4 = __attribute__((ext_vector_type(4))) short;
using f32x16 = __attribute__((ext_vector_type(16))) float;
using u32x4 = __attribute__((ext_vector_type(4))) unsigned;
constexpr int SEQ = 2048, PW = 6144, DMODEL = 2048, KVBLK = 64, QB = 128;
constexpr int SHM_V = KVBLK * 128 * 2, SHM_K = KVBLK * 128 * 2;
constexpr int NSLOT = 3, SLOTB = SHM_K + SHM_V;
constexpr int LDS_WS = NSLOT * SLOTB, LDS_BT = LDS_WS + 8 * 64 * 4, LDS_END = LDS_BT + 2 * 384 * 4;
constexpr float THR2 = 8.0f;
#define KSWZ(row, colB) ((row) * 256 + ((colB) ^ (((row) & 7) << 4)))
#define SBAR() __builtin_amdgcn_sched_barrier(0)
__device__ __forceinline__ int crow(int r, int hi) { return (r & 3) + 8 * (r >> 2) + 4 * hi; }
__device__ __forceinline__ unsigned cvtpk(float lo, float hi) { unsigned r; asm volatile("v_cvt_pk_bf16_f32 %0, %1, %2" : "=v"(r) : "v"(lo), "v"(hi)); return r; }
__device__ __forceinline__ void partialSM(f32x16& p0, f32x16& p1, float& m_reg, float& alpha, float cadd) {
  float pmax = p0[0];
#pragma unroll
  for (int r = 1; r < 16; ++r) pmax = fmaxf(pmax, p0[r]);
#pragma unroll
  for (int r = 0; r < 16; ++r) pmax = fmaxf(pmax, p1[r]);
  { auto rr = __builtin_amdgcn_permlane32_swap(__float_as_uint(pmax), __float_as_uint(pmax), false, false);
    pmax = fmaxf(__uint_as_float(rr[0]), __uint_as_float(rr[1])) + cadd; }
  if (__builtin_expect(__all(pmax - m_reg <= THR2), 1)) { alpha = 1.f; }
  else { const float mn = fmaxf(m_reg, pmax); alpha = __builtin_amdgcn_exp2f(m_reg - mn); m_reg = mn; }
  const float sh = cadd - m_reg;
#pragma unroll
  for (int r = 0; r < 16; ++r) { p0[r] += sh; p1[r] += sh; }
#pragma unroll
  for (int r = 0; r < 16; ++r) p0[r] = __builtin_amdgcn_exp2f(p0[r]);
}
__device__ __forceinline__ void finishSM(f32x16& p0, f32x16& p1, float alpha, float& l_reg, bf16x8& pa0, bf16x8& pa1, bf16x8& pa2, bf16x8& pa3) {
#pragma unroll
  for (int r = 0; r < 16; ++r) p1[r] = __builtin_amdgcn_exp2f(p1[r]);
  float ps = 0;
#pragma unroll
  for (int r = 0; r < 16; ++r) ps += p0[r];
#pragma unroll
  for (int r = 0; r < 16; ++r) ps += p1[r];
  { auto rr = __builtin_amdgcn_permlane32_swap(__float_as_uint(ps), __float_as_uint(ps), false, false);
    ps = __uint_as_float(rr[0]) + __uint_as_float(rr[1]); }
  l_reg = l_reg * alpha + ps;
#define PK4(P, BASE, OUT) do { unsigned a0 = cvtpk(P[BASE + 0], P[BASE + 1]), a1 = cvtpk(P[BASE + 2], P[BASE + 3]);   \
    unsigned b0 = cvtpk(P[BASE + 4], P[BASE + 5]), b1 = cvtpk(P[BASE + 6], P[BASE + 7]);                              \
    auto r0 = __builtin_amdgcn_permlane32_swap(a0, b0, false, false); auto r1 = __builtin_amdgcn_permlane32_swap(a1, b1, false, false); \
    u32x4 w = {r0[0], r1[0], r0[1], r1[1]}; OUT = *reinterpret_cast<bf16x8*>(&w); } while (0)
  PK4(p0, 0, pa0); PK4(p0, 8, pa1); PK4(p1, 0, pa2); PK4(p1, 8, pa3);
#undef PK4
}
__device__ __forceinline__ void qkt(f32x16& p0, f32x16& p1, const char* Ks, const bf16x8* qr, int r32, int hi, int m, const f32x16& cinit) {
  bf16x8 kf[8];
#pragma unroll
  for (int d0 = 0; d0 < 4; ++d0) { const int cb = (m * 64 + d0 * 16 + hi * 8) * 2;
    kf[2 * d0] = *reinterpret_cast<const bf16x8*>(Ks + KSWZ(r32, cb)); kf[2 * d0 + 1] = *reinterpret_cast<const bf16x8*>(Ks + KSWZ(32 + r32, cb)); }
  SBAR();
  p0 = __builtin_amdgcn_mfma_f32_32x32x16_bf16(kf[0], qr[0], cinit, 0, 0, 0);
  p1 = __builtin_amdgcn_mfma_f32_32x32x16_bf16(kf[1], qr[0], cinit, 0, 0, 0);
#pragma unroll
  for (int d0 = 1; d0 < 4; ++d0) {
    p0 = __builtin_amdgcn_mfma_f32_32x32x16_bf16(kf[2 * d0], qr[d0], p0, 0, 0, 0);
    p1 = __builtin_amdgcn_mfma_f32_32x32x16_bf16(kf[2 * d0 + 1], qr[d0], p1, 0, 0, 0); }
  SBAR();
}
__device__ __forceinline__ void bias_mask(f32x16& p0, f32x16& p1, const float* bt, int base) {
#pragma unroll
  for (int r = 0; r < 16; ++r) { const int c = (r & 3) + 8 * (r >> 2); p0[r] += bt[base - c]; }
  SBAR();
#pragma unroll
  for (int r = 0; r < 16; ++r) { const int c = (r & 3) + 8 * (r >> 2); p1[r] += bt[base - c - 32]; }
}
__device__ __forceinline__ int v_st(int k, int c) { const int kk = (k & ~0xC) | ((k & 4) << 1) | ((k & 8) >> 1); return ((kk >> 3) * 4 + (c >> 5)) * 512 + ((kk & 7) * 32 + (c & 31)) * 2; }
__device__ __forceinline__ int v_rd_base(int lane) { return ((lane & 3) << 3) | (((lane >> 2) & 3) << 6) | (((lane >> 4) & 1) << 5) | (((lane >> 5) & 1) << 8); }
constexpr int v_rd_off(int d0, int ks, int half) { return d0 * 512 + ks * 4096 + half * 2048; }
typedef short v4i16_t __attribute__((ext_vector_type(4)));
typedef __attribute__((address_space(3))) const char* lds_cptr;
__device__ __forceinline__ s16x4 vtr(lds_cptr p) { return __builtin_bit_cast(s16x4, __builtin_amdgcn_ds_read_tr16_b64_v4i16((__attribute__((address_space(3))) v4i16_t*)p)); }
struct VFrag { s16x4 lo[4], hi[4]; };
template <int KS> __device__ __forceinline__ void v_read(VFrag& f, lds_cptr vp) {
#pragma unroll
  for (int d0 = 0; d0 < 4; ++d0) { f.lo[d0] = vtr(vp + v_rd_off(d0, KS, 0)); f.hi[d0] = vtr(vp + v_rd_off(d0, KS, 1)); }
}
__device__ __forceinline__ void pv_slice(f32x16* o, const VFrag& f, bf16x8 pa) {
#pragma unroll
  for (int d0 = 0; d0 < 4; ++d0) { const bf16x8 vf = (bf16x8){f.lo[d0][0], f.lo[d0][1], f.lo[d0][2], f.lo[d0][3], f.hi[d0][0], f.hi[d0][1], f.hi[d0][2], f.hi[d0][3]};
    o[d0] = __builtin_amdgcn_mfma_f32_32x32x16_bf16(pa, vf, o[d0], 0, 0, 0); }
}
__device__ __forceinline__ void pv_all(f32x16* o, lds_cptr vp, bf16x8 pa0, bf16x8 pa1, bf16x8 pa2, bf16x8 pa3) {
  VFrag fa, fb;
  v_read<0>(fa, vp); v_read<1>(fb, vp); SBAR();
  pv_slice(o, fa, pa0); SBAR(); v_read<2>(fa, vp); SBAR();
  pv_slice(o, fb, pa1); SBAR(); v_read<3>(fb, vp); SBAR();
  pv_slice(o, fa, pa2); SBAR();
  pv_slice(o, fb, pa3); SBAR();
}
__device__ __forceinline__ void conv_item(const bf16* __restrict__ P, bf16* __restrict__ MIX, const float* __restrict__ cw, int it, int lane) {
  const unsigned short* Pu = reinterpret_cast<const unsigned short*>(P); unsigned short* Mu = reinterpret_cast<unsigned short*>(MIX);
  const int t0 = it * 4; const bool first = (t0 % SEQ) == 0;
#pragma unroll
  for (int j = 0; j < 2; ++j) { const int c0 = j * 512 + lane * 8;
    float w0[8], w1[8], w2[8];
#pragma unroll
    for (int e = 0; e < 8; ++e) { w0[e] = cw[c0 + e]; w1[e] = cw[1024 + c0 + e]; w2[e] = cw[2048 + c0 + e]; }
    float p[6][8];
#pragma unroll
    for (int k = 0; k < 6; ++k) { const int t = t0 - 2 + k;
      if (k < 2 && first) {
#pragma unroll
        for (int e = 0; e < 8; ++e) p[k][e] = 0.f;
      } else { const u32x4 gp = *(const u32x4*)(Pu + (size_t)t * PW + 4096 + c0);
#pragma unroll
        for (int e = 0; e < 4; ++e) { p[k][2 * e] = __uint_as_float(gp[e] << 16); p[k][2 * e + 1] = __uint_as_float(gp[e] & 0xffff0000u); } } }
#pragma unroll
    for (int i = 0; i < 4; ++i) { const u32x4 gb = *(const u32x4*)(Pu + (size_t)(t0 + i) * PW + 3072 + c0); float r[8];
#pragma unroll
      for (int e = 0; e < 4; ++e) { r[2 * e] = __uint_as_float(gb[e] << 16) * (w0[2 * e] * p[i][2 * e] + w1[2 * e] * p[i + 1][2 * e] + w2[2 * e] * p[i + 2][2 * e]);
        r[2 * e + 1] = __uint_as_float(gb[e] & 0xffff0000u) * (w0[2 * e + 1] * p[i][2 * e + 1] + w1[2 * e + 1] * p[i + 1][2 * e + 1] + w2[2 * e + 1] * p[i + 2][2 * e + 1]); }
      u32x4 o; o.x = cvtpk(r[0], r[1]); o.y = cvtpk(r[2], r[3]); o.z = cvtpk(r[4], r[5]); o.w = cvtpk(r[6], r[7]);
      *(u32x4*)(Mu + (size_t)(t0 + i) * DMODEL + 1024 + c0) = o; } }
}
template <bool FIXED> __device__ __forceinline__ void attn_unit(int b, int h, int qb, const bf16* __restrict__ P, bf16* __restrict__ MIX, const float* __restrict__ BT, const float* __restrict__ subg,
                                          float lam, float post, float sref, const float* __restrict__ cw, int conv_base, char* lds) {
  int tid_ = threadIdx.x; asm volatile("" : "+v"(tid_));
  const int tid = tid_, lane = tid & 63, r32 = lane & 31, hi = lane >> 5;
  const int wid = __builtin_amdgcn_readfirstlane(tid >> 6), m = wid >> 2, wq = wid & 3;
  const long rowbase = (long)b * SEQ; const int q0 = qb * QB, qw0 = q0 + wq * 32;
  float* ws = (float*)(lds + LDS_WS) + wid * 64; float* li_l = ws; float* al_l = ws + 32;
  float* btl = (float*)(lds + LDS_BT);
  for (int i = tid; i < 768; i += 512) btl[i] = BT[(size_t)h * 768 + i] - (FIXED ? sref : 0.f);
  const float* bt = btl + m * 384 + 128;
  const float c31 = BT[(size_t)h * 768 + m * 384 + 128 + 127] - (FIXED ? sref : 0.f);
  f32x16 cfar, czero = f32x16{};
#pragma unroll
  for (int r = 0; r < 16; ++r) cfar[r] = FIXED ? c31 : 0.f;
  float m_reg = -1e30f, l_reg = 0.f; f32x16 o[4] = {}; bf16x8 qr[4];
  const bf16* Qw = P + (rowbase + qw0 + r32) * PW + h * 128 + m * 64 + hi * 8;
#pragma unroll
  for (int d0 = 0; d0 < 4; ++d0) qr[d0] = *reinterpret_cast<const bf16x8*>(Qw + d0 * 16);
  const bf16* Kh = P + rowbase * PW + 1024 + h * 128; const bf16* Vh = P + rowbase * PW + 2048 + h * 128;
  unsigned ksrc[2], vsrc[2];
#pragma unroll
  for (int i = 0; i < 2; ++i) { const int pk = wid * 2 + i;
    { const int row = 4 * pk + (lane >> 4), cc = lane & 15; ksrc[i] = (unsigned)(row * PW + ((cc ^ (row & 7)) * 8)); }
    { const int ob = pk * 1024 + lane * 16, sub = ob >> 9, kk = (sub >> 2) * 8 + ((ob & 511) >> 6), k = (kk & ~0xC) | ((kk & 4) << 1) | ((kk & 8) >> 1), c = (sub & 3) * 32 + ((ob & 63) >> 1);
      vsrc[i] = (unsigned)(k * PW + c); } }
  typedef __attribute__((address_space(3))) unsigned lds_u32;
  typedef __attribute__((address_space(3))) unsigned char lds_u8;
  lds_u8* const ring = (lds_u8*)lds + wid * 2048;
#define DMA_TILE(t, slot) do { const bf16* kg_ = Kh + (long)(t) * KVBLK * PW; const bf16* vg_ = Vh + (long)(t) * KVBLK * PW; \
    _Pragma("unroll") for (int i_ = 0; i_ < 2; ++i_) { \
      __builtin_amdgcn_global_load_lds((const unsigned*)(kg_ + ksrc[i_]), (lds_u32*)(ring + (slot) * SLOTB + i_ * 1024), 16, 0, 0); \
      __builtin_amdgcn_global_load_lds((const unsigned*)(vg_ + vsrc[i_]), (lds_u32*)(ring + (slot) * SLOTB + SHM_K + i_ * 1024), 16, 0, 0); } } while (0)
#define WAIT_BAR(N) asm volatile("s_waitcnt vmcnt(" #N ") lgkmcnt(0)\n\ts_barrier" ::: "memory")
  const lds_cptr vp0 = (lds_cptr)lds + SHM_K + v_rd_base(lane);
#define RESC(a) do { if (__any((a) < 1.f)) { if (hi == 0) al_l[r32] = (a); asm volatile("s_waitcnt lgkmcnt(0)" ::: "memory"); \
    _Pragma("unroll") for (int d = 0; d < 4; ++d) _Pragma("unroll") for (int r = 0; r < 16; ++r) o[d][r] *= al_l[crow(r, hi)]; } } while (0)
#define SCORE(P0, P1, Kbuf, t, CADD) do { const int dmin_ = qw0 - 64 * (t) - 63; const bool far_ = dmin_ >= 113; CADD = (far_ && !FIXED) ? c31 : 0.f; \
    if (FIXED && far_) { qkt(P0, P1, Kbuf, qr, r32, hi, m, cfar); } \
    else { qkt(P0, P1, Kbuf, qr, r32, hi, m, czero); if (!far_) bias_mask(P0, P1, bt, qw0 + r32 - 64 * (t) - 4 * hi); } } while (0)
  f32x16 p0, p1; float al, ca; bf16x8 pa0, pa1, pa2, pa3; const int NT = 2 * qb + 2;
#ifndef ATT_REP
#define ATT_REP 1
#endif
  const int NTT = ATT_REP * NT;
  DMA_TILE(0, 0); DMA_TILE(1, 1);
  WAIT_BAR(4);
  int slot = 0;
  for (int tt = 0; tt < NTT; ++tt) {
    const int t = (ATT_REP == 1) ? tt : (tt % NT), t2 = (ATT_REP == 1) ? tt + 2 : ((tt + 2) % NT);
    const int s2 = (slot >= 1) ? slot - 1 : 2;
    if (tt + 2 < NTT) DMA_TILE(t2, s2);
    SBAR();
#ifndef ATT_CREP
#define ATT_CREP 1
#endif
#pragma unroll 1
    for (int crep = 0; crep < ATT_CREP; ++crep) {
    SCORE(p0, p1, lds + slot * SLOTB, t, ca);
    if constexpr (FIXED) {
#pragma unroll
      for (int r = 0; r < 16; ++r) p0[r] = __builtin_amdgcn_exp2f(p0[r]);
      finishSM(p0, p1, 1.f, l_reg, pa0, pa1, pa2, pa3); SBAR();
    } else {
      partialSM(p0, p1, m_reg, al, ca);
      RESC(al);
      finishSM(p0, p1, al, l_reg, pa0, pa1, pa2, pa3); SBAR();
    }
    pv_all(o, vp0 + slot * SLOTB, pa0, pa1, pa2, pa3);
    }
    if (tt + 2 < NTT) WAIT_BAR(4); else WAIT_BAR(0);
    slot = (slot == 2) ? 0 : slot + 1;
  }
  if (hi == 0) li_l[r32] = l_reg; asm volatile("s_waitcnt lgkmcnt(0)" ::: "memory");
  float rli[16];
#pragma unroll
  for (int r = 0; r < 16; ++r) rli[r] = __builtin_amdgcn_rcpf(li_l[crow(r, hi)]);
  __syncthreads();
  float* xch = (float*)lds + wq * 4096 + lane;
  if (m == 1) {
#pragma unroll
    for (int d0 = 0; d0 < 4; ++d0)
#pragma unroll
      for (int r = 0; r < 16; ++r) xch[(d0 * 16 + r) * 64] = o[d0][r] * rli[r] * lam;
  }
  __syncthreads();
  if (m == 0) {
    bf16* Ow = MIX + (rowbase + qw0) * DMODEL + h * 128 + r32;
    float gsub[4];
#pragma unroll
    for (int d0 = 0; d0 < 4; ++d0) gsub[d0] = subg[d0 * 32 + r32] * post;
#pragma unroll
    for (int r = 0; r < 16; ++r) { float y[4]; float ss = 0.f;
#pragma unroll
      for (int d0 = 0; d0 < 4; ++d0) { y[d0] = o[d0][r] * rli[r] - xch[(d0 * 16 + r) * 64]; ss += y[d0] * y[d0]; }
      ss += __shfl_xor(ss, 1); ss += __shfl_xor(ss, 2); ss += __shfl_xor(ss, 4); ss += __shfl_xor(ss, 8); ss += __shfl_xor(ss, 16);
      const float rs = 1.0f / sqrtf(ss * (1.0f / 128.0f) + 1e-6f);
#pragma unroll
      for (int d0 = 0; d0 < 4; ++d0) Ow[(long)crow(r, hi) * DMODEL + d0 * 32] = __float2bfloat16(y[d0] * rs * gsub[d0]); }
  }
  if (m == 1) conv_item(P, MIX, cw, conv_base + wq, lane);
  __syncthreads();
#undef DMA_TILE
#undef WAIT_BAR
#undef RESC
#undef SCORE
}
#undef KSWZ
#undef SBAR
}
#ifndef DUP
#define DUP 0
#endif
#ifndef NO_CONV
#define NO_CONV 0
#endif
#ifndef NO_ATTU
#define NO_ATTU 0
#endif
#ifndef NO_P0
#define NO_P0 0
#endif
#ifndef NO_PROJ
#define NO_PROJ 0
#endif
#ifndef NO_ATT
#define NO_ATT 0
#endif
#ifndef NO_OUT
#define NO_OUT 0
#endif
#ifndef NO_UP
#define NO_UP 0
#endif
#ifndef NO_DN
#define NO_DN 0
#endif
#ifndef MK_PER_PHASE
#define MK_PER_PHASE 0
#endif
constexpr int NWAVES = 8;
constexpr int BATCH = 4, SEQ = 2048, T = BATCH * SEQ, D = 2048, PW = 6144, FF = 8192, NH = 8, DEPTH = 4, CONVW = 1024;
constexpr int N_PHASES = 1 + 5 * DEPTH;
constexpr size_t MiB = 1u << 20;
constexpr size_t WS_SSQ = 674 * MiB;
constexpr size_t WS_CTL = 0, CTL_ZERO_BYTES = 64 * 1024;
constexpr size_t WS_BT = 512 * 1024;
constexpr size_t WS_WIN = 2 * MiB, WS_WOUT = 98 * MiB, WS_WUP = 130 * MiB, WS_WDN = 258 * MiB;
constexpr size_t WS_XB = 386 * MiB, WS_PROJ = 418 * MiB, WS_MIX = 514 * MiB, WS_U = 546 * MiB, WS_END = 684 * MiB;
constexpr int LDS_BYTES = 147456, LDS_BARST = LDS_BYTES - 64;
#define LAS __attribute__((address_space(3)))
#define XB_TMO      128
#define XB_XCNT(j)  (256  + 64 * (j))
#define XB_XSUB(j)  (1280 + 64 * (j))
#define XB_XGEN(j)  (2304 + 64 * (j))
#define XB_TOP      3328
#define XB_TOPGEN   3392
#define XCD_BAR_WORDS 3456
#define XB_SPIN_CAP (1u << 18)

__device__ __forceinline__ unsigned xb_ld(unsigned* p)              { return __hip_atomic_load(p, __ATOMIC_RELAXED, __HIP_MEMORY_SCOPE_AGENT); }
__device__ __forceinline__ unsigned xb_add(unsigned* p, unsigned v) { return __hip_atomic_fetch_add(p, v, __ATOMIC_RELAXED, __HIP_MEMORY_SCOPE_AGENT); }
__device__ __forceinline__ unsigned xb_xcc_id() { return (unsigned)__builtin_amdgcn_s_getreg((3 << 11) | 20) & 0xFu; }
#define XB_SPIN(cond, bar) do { unsigned _sp = 0; while (cond) { __builtin_amdgcn_s_sleep(1); \
    if ((++_sp & 255u) == 0u) { if (xb_ld(&(bar)[XB_TMO])) break; if (_sp > XB_SPIN_CAP) { atomicAdd(&(bar)[XB_TMO], 1u); break; } } } } while (0)

struct XcdBarrier {
    unsigned* bar; unsigned x;
    volatile LAS unsigned* st;
};

__device__ __forceinline__ XcdBarrier xcd_barrier_post(unsigned* bar, volatile LAS unsigned* st) {
    XcdBarrier b; b.bar = bar; b.x = xb_xcc_id(); b.st = st;
    if (threadIdx.x == 0) (void)xb_add(&bar[XB_XCNT(b.x)], 1u);
    return b;
}
__device__ __forceinline__ void xcd_barrier_complete(unsigned* bar, unsigned x, unsigned& nloc, unsigned& nx) {
    const unsigned G = gridDim.x * gridDim.y * gridDim.z;
    unsigned sum, cnt, mine, sp = 0u;
    for (;;) {
        sum = 0u; cnt = 0u; mine = 0u;
#pragma unroll
        for (unsigned j = 0; j < 16; ++j) { const unsigned c = xb_ld(&bar[XB_XCNT(j)]); sum += c; cnt += (c > 0u) ? 1u : 0u; mine = (j == x) ? c : mine; }
        if (sum == G) break;
        __builtin_amdgcn_s_sleep(1);
        if ((++sp & 255u) == 0u) { if (xb_ld(&bar[XB_TMO])) break; if (sp > XB_SPIN_CAP) { atomicAdd(&bar[XB_TMO], 1u); break; } }
    }
    nloc = mine > 0u ? mine : 1u; nx = cnt > 0u ? cnt : 1u;
}

__device__ __forceinline__ void xcd_barrier(const XcdBarrier& b) {
    asm volatile("s_waitcnt vmcnt(0)" ::: "memory");
    __syncthreads();
    if (threadIdx.x == 0) {
        unsigned* bar = b.bar;
        __builtin_amdgcn_s_waitcnt(0);
        unsigned nloc = b.st[0], nx = b.st[1];
        if (nloc == 0u) { xcd_barrier_complete(bar, b.x, nloc, nx); b.st[0] = nloc; b.st[1] = nx; }
        const unsigned old = xb_add(&bar[XB_XSUB(b.x)], 1u);
        const unsigned gen = old / nloc;
        if (old + 1u == (gen + 1u) * nloc) {
            __builtin_amdgcn_fence(__ATOMIC_RELEASE, "agent");
            asm volatile("s_waitcnt vmcnt(0)" ::: "memory");
            const unsigned og = xb_add(&bar[XB_TOP], 1u);
            const unsigned tg = og / nx;
            if (og + 1u == (tg + 1u) * nx) xb_add(&bar[XB_TOPGEN], 1u);
            else XB_SPIN(xb_ld(&bar[XB_TOPGEN]) == tg, bar);
            __builtin_amdgcn_fence(__ATOMIC_ACQUIRE, "agent");
            xb_add(&bar[XB_XGEN(b.x)], 1u);
            asm volatile("s_waitcnt vmcnt(0)" ::: "memory");
        } else {
            XB_SPIN(xb_ld(&bar[XB_XGEN(b.x)]) == gen, bar);
            __builtin_amdgcn_fence(__ATOMIC_ACQUIRE, "agent");
            asm volatile("s_waitcnt vmcnt(0)" ::: "memory");
        }
    }
    __syncthreads();
}

typedef unsigned short bf16;
typedef unsigned v4u __attribute__((ext_vector_type(4)));
typedef float f32x4 __attribute__((ext_vector_type(4)));
__device__ __forceinline__ unsigned f2bf(float f) { unsigned u = __builtin_bit_cast(unsigned, f); return (u + 0x7fffu + ((u >> 16) & 1u)) >> 16; }
__device__ __forceinline__ unsigned pk2(float lo, float hi) { return f2bf(lo) | (f2bf(hi) << 16); }
__device__ __forceinline__ float wave_sum(float v) {
#pragma unroll
    for (int o = 1; o < 64; o <<= 1) v += __shfl_xor(v, o);
    return v;
}
__device__ __forceinline__ int win_row(int n) {
    if (n >= 4096) { const int isci = n >= 5120 ? 1 : 0, ch = n - (isci ? 5120 : 4096); return (16 + (ch >> 7)) * 256 + isci * 128 + (ch & 127); }
    const int c = n & 255; return (n & ~255) + ((c >> 5) & 1) * 128 + (c >> 6) * 32 + (c & 31); }
struct TItem { const float* src; const float* g; bf16* dst; int N, K, perm; };
__device__ __forceinline__ void titem_load(const TItem& d, f32x4 (&v)[16], float (&gg)[16], int lane) {
#pragma unroll
    for (int i = 0; i < 16; ++i) { const int kk = 32 * (i >> 3) + 8 * (lane >> 4) + (i & 7); v[i] = *(const f32x4*)(d.src + (size_t)kk * d.N + (lane & 15) * 4); gg[i] = d.g ? d.g[kk] : 1.f; }
}
__device__ __forceinline__ void titem_process(const TItem& d, const f32x4 (&v)[16], const float (&gg)[16], int lane) {
    const int n0 = d.perm >> 1;
#pragma unroll
    for (int j = 0; j < 4; ++j) { const int n = n0 + 4 * (lane & 15) + j, nr = (d.perm & 1) ? win_row(n) : n;
        const int w32 = nr & 31, nrs = (nr & 255 & ~31) + 16 * ((w32 >> 2) & 1) + 4 * (w32 >> 3) + (w32 & 3);
        bf16* rowp = d.dst + (size_t)(nr >> 8) * (d.K >> 6) * (256 * 64);
#pragma unroll
        for (int h = 0; h < 2; ++h) { v4u o;
            o.x = pg8::cvt_pk_bf16(v[8 * h + 0][j] * gg[8 * h + 0], v[8 * h + 1][j] * gg[8 * h + 1]); o.y = pg8::cvt_pk_bf16(v[8 * h + 2][j] * gg[8 * h + 2], v[8 * h + 3][j] * gg[8 * h + 3]);
            o.z = pg8::cvt_pk_bf16(v[8 * h + 4][j] * gg[8 * h + 4], v[8 * h + 5][j] * gg[8 * h + 5]); o.w = pg8::cvt_pk_bf16(v[8 * h + 6][j] * gg[8 * h + 6], v[8 * h + 7][j] * gg[8 * h + 7]);
            *(v4u*)(rowp + pg8::blk_off(nrs, 8 * (lane >> 4) + 32 * h)) = o; } }
}
__device__ __forceinline__ int t5_bucket(int d) {
    if (d < 16) return d;
    const int th[15] = {19, 21, 24, 27, 31, 35, 40, 46, 52, 59, 67, 77, 87, 99, 113};
    int b = 16;
#pragma unroll
    for (int i = 0; i < 15; ++i) b += (d >= th[i]) ? 1 : 0;
    return b;
}
struct Args { const float* in[18]; int ph_lo, ph_hi; };

__global__ void __launch_bounds__(NWAVES * 64, 2) hybrid_fwd(Args args) {
    extern __shared__ __attribute__((aligned(16))) unsigned char lds[];
    cg::grid_group grid = cg::this_grid();
    const int tid = threadIdx.x, lane = tid & 63, wave = __builtin_amdgcn_readfirstlane(tid >> 6);
    const int G = gridDim.x, bx = blockIdx.x;
    const int vcu = (G % 8 == 0) ? (bx % 8) * (G / 8) + bx / 8 : bx;
    const int lo = args.ph_lo, hi = args.ph_hi;
    if (tid < 16) ((volatile LAS unsigned*)((LAS unsigned char*)lds + LDS_BARST))[tid] = 0u;
    __syncthreads();
    const XcdBarrier xbar = xcd_barrier_post((unsigned*)args.in[17], (volatile LAS unsigned*)((LAS unsigned char*)lds + LDS_BARST));
#define IN(k) (lo <= (k) && (k) < hi)
#ifdef NO_SYNC
#define SEAM(k) do { } while (0)
#else
#define SEAM(k) do { if ((k) + 1 < hi) { if ((k) == 0) grid.sync(); else xcd_barrier(xbar); if (DUP & 16) { xcd_barrier(xbar); xcd_barrier(xbar); } } } while (0)
#endif

    for (int rep = 0; rep < ((DUP & 1) ? 2 : 1); ++rep)
    if (IN(0) && !NO_P0) {
        int z = 0; asm volatile("" : "+s"(z));
        unsigned char* ws = (unsigned char*)args.in[z + 17]; float* ssq = (float*)(ws + WS_SSQ); float* BT = (float*)(ws + WS_BT); bf16* XB = (bf16*)(ws + WS_XB);
        const int gw = vcu * NWAVES + wave, NGW = G * NWAVES;
        constexpr int I_IN = (D / 64) * (PW / 64), I_OUT = (D / 64) * (D / 64), I_UP = (D / 64) * (FF / 64), I_DN = (FF / 64) * (D / 64), I_L = I_IN + I_OUT + I_UP + I_DN;
        const float* const w_in = args.in[z + 1]; const float* const w_out = args.in[z + 2]; const float* const w_up = args.in[z + 13]; const float* const w_dn = args.in[z + 14];
        const float* const g_attn = args.in[z + 11]; const float* const g_mlp = args.in[z + 12];
        auto decode = [&](int it) -> TItem {
            const int l = it / I_L; int r = it % I_L; TItem d;
            const float* W; bf16* WT; const float* g = nullptr; int K = D, N = D, perm = 0;
            if (r < I_IN) { W = w_in + (size_t)l * D * PW; WT = (bf16*)(ws + WS_WIN) + (size_t)l * PW * D; N = PW; g = g_attn + l * D; perm = 1; }
            else if ((r -= I_IN) < I_OUT) { W = w_out + (size_t)l * D * D; WT = (bf16*)(ws + WS_WOUT) + (size_t)l * D * D; }
            else if ((r -= I_OUT) < I_UP) { W = w_up + (size_t)l * D * FF; WT = (bf16*)(ws + WS_WUP) + (size_t)l * FF * D; N = FF; g = g_mlp + l * D; }
            else { r -= I_UP; W = w_dn + (size_t)l * FF * D; WT = (bf16*)(ws + WS_WDN) + (size_t)l * D * FF; K = FF; }
            const int nblk = N / 64, k0 = 64 * (r / nblk), n0 = 64 * (r % nblk);
            d.src = W + (size_t)k0 * N + n0; d.g = g ? g + k0 : nullptr; d.dst = WT + (size_t)(k0 >> 6) * (256 * 64); d.N = N; d.K = K; d.perm = perm | (n0 << 1);
            return d; };
        {
            int it = gw; f32x4 va[16]; float ga[16]; TItem d0;
            if (it < DEPTH * I_L) { d0 = decode(it); titem_load(d0, va, ga, lane); }
            while (it < DEPTH * I_L) {
                const int itn = it + NGW; f32x4 vb[16]; float gb[16]; TItem d1;
                if (itn < DEPTH * I_L) { d1 = decode(itn); titem_load(d1, vb, gb, lane); }
                titem_process(d0, va, ga, lane);
                if (itn < DEPTH * I_L) {
#pragma unroll
                    for (int i = 0; i < 16; ++i) { va[i] = vb[i]; ga[i] = gb[i]; }
                    d0 = d1; }
                it = itn;
            }
        }
        const int gt = bx * (NWAVES * 64) + tid, NGT = G * NWAVES * 64;
        for (int i = gt; i < 16 * 384; i += NGT) { const int hm = i / 384, d = i % 384 - 128;
            BT[i] = d < 0 ? -1e30f : args.in[z + 15][t5_bucket(d > 127 ? 127 : d) * 16 + hm] * 1.4426950408889634f; }
        const float* x = args.in[z + 0];
        for (int row = gw; row < T; row += NGW) {
            const f32x4* xr = (const f32x4*)(x + (size_t)row * D) + lane; float s = 0.f;
            bf16* const xbrow = XB + (size_t)(row >> 8) * (D / 64) * (256 * 64);
#pragma unroll
            for (int j = 0; j < 8; ++j) { const f32x4 v = xr[64 * j]; s += (v[0] * v[0] + v[1] * v[1]) + (v[2] * v[2] + v[3] * v[3]);
                { const int col = 256 * j + 4 * lane; *(unsigned long long*)(xbrow + (size_t)(col >> 6) * (256 * 64) + pg8::blk_off(row & 255, col & 63)) = (unsigned long long)pk2(v[0], v[1]) | ((unsigned long long)pk2(v[2], v[3]) << 32); } }
            s = wave_sum(s); if (lane < 32) ssq[(size_t)row * 32 + lane] = (lane == 0) ? s : 0.f;
        }
        SEAM(0);
    }

    for (int l = 0; l < DEPTH; ++l) {
        const int p0 = 1 + 5 * l;
        for (int rep = 0; rep < ((DUP & 2) ? 2 : 1); ++rep)
        if (IN(p0) && !NO_PROJ) {
            int ll = l, z = 0; asm volatile("" : "+s"(ll), "+s"(z));
            unsigned char* w = (unsigned char*)args.in[z + 17]; float* xout = (float*)args.in[z + 16];
            pg8::Gemm g{(const bf16*)(w + WS_XB), (const bf16*)(w + WS_WIN) + (size_t)ll * PW * D, T, PW, D, 1  }; pg8::StaticOrder S; S.init(T, PW, G, bx);
            pg8::EpiProj E{(bf16*)(w + WS_PROJ), (const float*)(w + WS_SSQ) + (size_t)(2 * ll) * T * 32, args.in[z + 4] + ll * 64, args.in[z + 5] + ll * 64, PW};
            pg8::gemm_phase<pg8::EpiProj, pg8::StaticOrder, true, true>((LAS unsigned char*)lds, g, S, E);
            SEAM(p0);
        }
        for (int rep = 0; rep < ((DUP & 4) ? 2 : 1); ++rep)
        if (IN(p0 + 1) && !NO_ATT) {
            int ll = l, z = 0; asm volatile("" : "+s"(ll), "+s"(z));
            unsigned char* w = (unsigned char*)args.in[z + 17]; float* xout = (float*)args.in[z + 16];
            const bf16* PROJ = (const bf16*)(w + WS_PROJ); bf16* MIX = (bf16*)(w + WS_MIX); const float* BT = (const float*)(w + WS_BT);
            const float lam_init = 0.8f - 0.6f * expf(-0.3f * (float)ll);
            float a = args.in[z + 6][ll * 64 + lane] * args.in[z + 7][ll * 64 + lane], b2 = args.in[z + 8][ll * 64 + lane] * args.in[z + 9][ll * 64 + lane];
            a = wave_sum(a); b2 = wave_sum(b2);
            const float lam = expf(a) - expf(b2) + lam_init;
            float gqm = fabsf(args.in[z + 4][ll * 64 + lane]), gkm = fabsf(args.in[z + 5][ll * 64 + lane]);
#pragma unroll
            for (int o = 1; o < 64; o <<= 1) { gqm = fmaxf(gqm, __shfl_xor(gqm, o)); gkm = fmaxf(gkm, __shfl_xor(gkm, o)); }
            const float gqk = gqm * gkm;
            for (int pr = vcu; pr < BATCH * NH * 8 && !NO_ATTU; pr += G) {
                const int bh = pr >> 3, s = pr & 7;
#pragma unroll 1
                for (int half = 0; half < 2; ++half)
                {   const int qb = half == 0 ? 15 - s : s, hh = bh % NH;
                    float bm = fmaxf(fmaxf(BT[hh * 768 + 128 + lane], BT[hh * 768 + 128 + 64 + lane]), fmaxf(BT[hh * 768 + 384 + 128 + lane], BT[hh * 768 + 384 + 128 + 64 + lane]));
#pragma unroll
                    for (int o = 1; o < 64; o <<= 1) bm = fmaxf(bm, __shfl_xor(bm, o));
                    const float sref = 11.8f * gqk + bm + 0.25f;
                    if (sref <= 40.f) att::attn_unit<true>(bh / NH, hh, qb, (const att::bf16*)PROJ, (att::bf16*)MIX, BT, args.in[z + 10] + ll * 128, lam, 1.0f - lam_init, sref, args.in[z + 3] + (size_t)ll * 3 * CONVW, pr * 8 + half * 4, (char*)lds);
                    else att::attn_unit<false>(bh / NH, hh, qb, (const att::bf16*)PROJ, (att::bf16*)MIX, BT, args.in[z + 10] + ll * 128, lam, 1.0f - lam_init, 0.f, args.in[z + 3] + (size_t)ll * 3 * CONVW, pr * 8 + half * 4, (char*)lds);
                }
            }
            SEAM(p0 + 1);
        }
        if (IN(p0 + 2) && !NO_OUT) {
            int ll = l, z = 0; asm volatile("" : "+s"(ll), "+s"(z));
            unsigned char* w = (unsigned char*)args.in[z + 17]; float* xout = (float*)args.in[z + 16];
            pg8::Gemm g{(const bf16*)(w + WS_MIX), (const bf16*)(w + WS_WOUT) + (size_t)ll * D * D, T, D, D, 0}; pg8::StaticOrder S; S.init(T, D, G, bx);
            pg8::EpiResid E{(ll == 0) ? args.in[z + 0] : (const float*)nullptr, (float*)nullptr, (bf16*)(w + WS_XB), (float*)(w + WS_SSQ) + (size_t)(2 * ll + 1) * T * 32, D};
            pg8::gemm_phase<pg8::EpiResid, pg8::StaticOrder, false, true>((LAS unsigned char*)lds, g, S, E);
            SEAM(p0 + 2);
        }
        for (int rep = 0; rep < ((DUP & 8) ? 2 : 1); ++rep)
        if (IN(p0 + 3) && !NO_UP) {
            int ll = l, z = 0; asm volatile("" : "+s"(ll), "+s"(z));
            unsigned char* w = (unsigned char*)args.in[z + 17]; float* xout = (float*)args.in[z + 16];
            pg8::Gemm g{(const bf16*)(w + WS_XB), (const bf16*)(w + WS_WUP) + (size_t)ll * FF * D, T, FF, D, 1  }; pg8::StaticOrder S; S.init(T, FF, G, bx);
            pg8::EpiUp E{(bf16*)(w + WS_U), (const float*)(w + WS_SSQ) + (size_t)(2 * ll + 1) * T * 32, FF};
            pg8::gemm_phase<pg8::EpiUp, pg8::StaticOrder, true, true>((LAS unsigned char*)lds, g, S, E);
            SEAM(p0 + 3);
        }
        if (IN(p0 + 4) && !NO_DN) {
            int ll = l, z = 0; asm volatile("" : "+s"(ll), "+s"(z));
            unsigned char* w = (unsigned char*)args.in[z + 17]; float* xout = (float*)args.in[z + 16];
            pg8::Gemm g{(const bf16*)(w + WS_U), (const bf16*)(w + WS_WDN) + (size_t)ll * D * FF, T, D, FF, 1  }; pg8::StaticOrder S; S.init(T, D, G, bx);
            pg8::EpiResid E{(const float*)nullptr, (ll == DEPTH - 1) ? xout : (float*)nullptr, (bf16*)(w + WS_XB), (float*)(w + WS_SSQ) + (size_t)(2 * ll + 2) * T * 32, D};
            pg8::gemm_phase<pg8::EpiResid, pg8::StaticOrder, false, true>((LAS unsigned char*)lds, g, S, E);
            SEAM(p0 + 4);
        }
    }
#undef IN
#undef SEAM
}

extern "C" void kernel_launch(void* const* d_in, const int* in_sizes, int n_in, void* d_out, int out_size, void* d_ws, size_t ws_size, hipStream_t stream) {
    static int grid = 0;
    if (grid == 0) {
        if (n_in != 16 || in_sizes[0] != T * D || out_size != T * D || ws_size < WS_END) { fprintf(stderr, "kernel_launch: unexpected shapes (n_in %d in0 %d out %d ws %zu); nothing launched\n", n_in, n_in > 0 ? in_sizes[0] : -1, out_size, ws_size); grid = -1; return; }
        int dev = 0, cus = 0, per_cu = 0;
        if (hipGetDevice(&dev) != hipSuccess || hipDeviceGetAttribute(&cus, hipDeviceAttributeMultiprocessorCount, dev) != hipSuccess) { fprintf(stderr, "kernel_launch: device query failed\n"); grid = -1; return; }
        if (hipFuncSetAttribute((const void*)hybrid_fwd, hipFuncAttributeMaxDynamicSharedMemorySize, LDS_BYTES) != hipSuccess) { fprintf(stderr, "kernel_launch: hipFuncSetAttribute failed\n"); grid = -1; return; }
        if (hipOccupancyMaxActiveBlocksPerMultiprocessor(&per_cu, (const void*)hybrid_fwd, NWAVES * 64, LDS_BYTES) != hipSuccess || per_cu < 1) { fprintf(stderr, "kernel_launch: occupancy query says %d blocks per CU\n", per_cu); per_cu = 1; }
        (void)hipGetLastError();
        grid = cus * per_cu;
        fprintf(stderr, "kernel_launch: grid %d (%d CUs x %d)\n", grid, cus, per_cu);
    }
    if (grid < 0) return;
    if (hipMemsetAsync((char*)d_ws + WS_CTL, 0, CTL_ZERO_BYTES, stream) != hipSuccess) { fprintf(stderr, "kernel_launch: hipMemsetAsync failed\n"); return; }
    Args a{};
    for (int i = 0; i < 16; ++i) a.in[i] = (const float*)d_in[i];
    a.in[16] = (const float*)d_out; a.in[17] = (const float*)d_ws;
#if MK_PER_PHASE
    for (int ph = 0; ph < N_PHASES; ++ph) { a.ph_lo = ph; a.ph_hi = ph + 1; hipLaunchKernelGGL(hybrid_fwd, dim3(grid), dim3(NWAVES * 64), LDS_BYTES, stream, a); }
#else
    a.ph_lo = 0; a.ph_hi = N_PHASES;
    void* kargs[] = {&a};
    const hipError_t e = hipLaunchCooperativeKernel((const void*)hybrid_fwd, dim3(grid), dim3(NWAVES * 64), kargs, LDS_BYTES, stream);
    if (e != hipSuccess) fprintf(stderr, "kernel_launch: cooperative launch failed: %s (grid %d)\n", hipGetErrorString(e), grid);
#endif
    const hipError_t le = hipPeekAtLastError();
    if (le != hipSuccess) fprintf(stderr, "kernel_launch: launch error %s\n", hipGetErrorName(le));
}
```
